# Optimizing an MI355X kernel written in HIP

```python
import math
import jax
import jax.numpy as jnp
from jax import lax
import numpy as np

D_MODEL = 1024
BATCH = 2
SEQ = 8192
DEPTH = 4

GRID_W = 64
CTX_LEN = 256
N_BRANCH = 4
BR_W = 384

S5_GROUP = 16
S5_GROUPS = BR_W // S5_GROUP
S5_STATE = 64
S5_DT_MIN = 1e-3
S5_DT_MAX = 1e-1

SGU_CHUNK = 128
SGU_HEADS = 6

SSD_HEADS = 6
SSD_HEAD_DIM = BR_W // SSD_HEADS
SSD_GROUPS = 2
SSD_STATE = 64
SSD_CHUNK = 128
SSD_CONV = 3
SSD_GN = SSD_GROUPS * SSD_STATE
SSD_CONV_CH = BR_W + 2 * SSD_GN
SSD_DT_MIN = 1e-3
SSD_DT_MAX = 1e-1

MLA_HEADS = 6
MLA_NOPE = 64
MLA_ROPE = 32
MLA_V = 64
MLA_QK = MLA_NOPE + MLA_ROPE
MLA_Q_LORA = 384
MLA_KV_LORA = 256
ATTN_BLOCK = 128
ROPE_BASE = 10000.0
ROPE_PAIRS_AXIS = MLA_ROPE // 4

FFN_HIDDEN = int(math.ceil(8 * D_MODEL / 3 / 256)) * 256

IN_SIZES = (BR_W, 2 * BR_W, BR_W + SSD_CONV_CH + 2 * SSD_HEADS, MLA_Q_LORA + MLA_KV_LORA + MLA_ROPE, N_BRANCH * D_MODEL)
IN_W = sum(IN_SIZES)

kernel_name = 'hybrid_s5_sgu_ssd_mla_prefix_dit'


def rms_norm(x, g, eps=1e-6):
    xf = x.astype(jnp.float32)
    y = xf * lax.rsqrt(jnp.mean(xf * xf, axis=-1, keepdims=True) + eps)
    return (y * g.astype(jnp.float32)).astype(x.dtype)


def layer_norm(x, g, b, eps=1e-5):
    xf = x.astype(jnp.float32)
    mu = jnp.mean(xf, axis=-1, keepdims=True)
    xc = xf - mu
    y = xc * lax.rsqrt(jnp.mean(xc * xc, axis=-1, keepdims=True) + eps)
    return (y * g.astype(jnp.float32) + b.astype(jnp.float32)).astype(x.dtype)


def split_cols(p, sizes):
    idx = [int(i) for i in np.cumsum(sizes)[:-1]]
    return jnp.split(p, idx, axis=-1)


def modulate(h, shift, scale):
    return h * (1.0 + scale) + shift


def s5_discretise(a_re, a_im, b_re, b_im, log_dt):
    f32 = jnp.float32
    a_re, a_im, b_re, b_im = a_re.astype(f32), a_im.astype(f32), b_re.astype(f32), b_im.astype(f32)
    dt = jnp.exp(log_dt.astype(f32))[:, None]
    mag = jnp.exp(a_re * dt)
    ang = a_im * dt
    ab_re = mag * jnp.cos(ang)
    ab_im = mag * jnp.sin(ang)
    den = a_re * a_re + a_im * a_im
    f_re = ((ab_re - 1.0) * a_re + ab_im * a_im) / den
    f_im = (ab_im * a_re - (ab_re - 1.0) * a_im) / den
    bb_re = f_re[..., None] * b_re - f_im[..., None] * b_im
    bb_im = f_re[..., None] * b_im + f_im[..., None] * b_re
    return ab_re, ab_im, bb_re, bb_im


def _affine_combine(e1, e2):
    a1r, a1i, b1r, b1i = e1
    a2r, a2i, b2r, b2i = e2
    return (a2r * a1r - a2i * a1i, a2r * a1i + a2i * a1r,
            a2r * b1r - a2i * b1i + b2r, a2r * b1i + a2i * b1r + b2i)


def s5_scan(ab_re, ab_im, bu_re, bu_im, reverse, h0=None):
    shape = bu_re.shape
    elems = (jnp.broadcast_to(ab_re, shape), jnp.broadcast_to(ab_im, shape), bu_re, bu_im)
    p_re, p_im, h_re, h_im = lax.associative_scan(_affine_combine, elems, axis=1, reverse=reverse)
    if h0 is not None:
        h0r, h0i = h0[0][:, None], h0[1][:, None]
        h_re, h_im = h_re + p_re * h0r - p_im * h0i, h_im + p_re * h0i + p_im * h0r
    return h_re, h_im


def s5_branch(u_lat, u_ctx, lp, need_ctx):
    f32 = jnp.float32

    def drive(u, bb_re, bb_im):
        ug = u.astype(f32).reshape(u.shape[0], u.shape[1], S5_GROUPS, S5_GROUP)
        return jnp.einsum('blgc,gpc->blgp', ug, bb_re), jnp.einsum('blgc,gpc->blgp', ug, bb_im)

    def read(h_re, h_im, c_re, c_im):
        y = jnp.einsum('gcp,blgp->blgc', c_re, h_re) - jnp.einsum('gcp,blgp->blgc', c_im, h_im)
        return y.reshape(y.shape[0], y.shape[1], BR_W)

    d_skip = lp['s5_d'].astype(f32)
    y_lat = d_skip * u_lat.astype(f32)
    y_ctx = d_skip * u_ctx.astype(f32) if need_ctx else None
    for d, rev in enumerate((False, True)):
        ab_re, ab_im, bb_re, bb_im = s5_discretise(lp['s5_a_re'][d], lp['s5_a_im'][d], lp['s5_b_re'][d], lp['s5_b_im'][d], lp['s5_log_dt'][d])
        c_re = lp['s5_c_re'][d].astype(f32)
        c_im = lp['s5_c_im'][d].astype(f32)
        h_re, h_im = s5_scan(ab_re, ab_im, *drive(u_ctx, bb_re, bb_im), reverse=rev)
        end = 0 if rev else -1
        h_last = (h_re[:, end], h_im[:, end])
        if need_ctx:
            y_ctx = y_ctx + read(h_re, h_im, c_re, c_im)
        h_re, h_im = s5_scan(ab_re, ab_im, *drive(u_lat, bb_re, bb_im), reverse=rev, h0=h_last)
        y_lat = y_lat + read(h_re, h_im, c_re, c_im)

    def glu(y, dtype):
        y = jax.nn.gelu(y.astype(dtype))
        return y * jax.nn.sigmoid(y @ lp['s5_w_glu'])

    return glu(y_lat, u_lat.dtype), (glu(y_ctx, u_ctx.dtype) if need_ctx else None)


def sgu_branch(z, lp):
    z = jax.nn.gelu(z)
    u, v = jnp.split(z, 2, axis=-1)
    v = layer_norm(v, lp['sgu_ln_g'], lp['sgu_ln_b'])
    bsz, L, _ = v.shape
    vc = v.reshape(bsz, L // SGU_CHUNK, SGU_CHUNK, SGU_HEADS, BR_W // SGU_HEADS)
    mixed = jnp.einsum('hts,bnshd->bnthd', lp['sgu_w_s'], vc) + lp['sgu_b_s'].T[:, :, None]
    return u * mixed.reshape(bsz, L, BR_W)


def conv_centred(x, w, b):
    y = lax.conv_general_dilated(x, w[:, None, :].astype(x.dtype), window_strides=(1,),
                                 padding=[((SSD_CONV - 1) // 2, SSD_CONV // 2)],
                                 dimension_numbers=('NWC', 'WIO', 'NWC'),
                                 feature_group_count=x.shape[-1])
    return y + b


def ssd_scan(x, dA, Bh, Ch, h0, want_y):
    b, L, H, P = x.shape
    N = Bh.shape[-1]
    T = SSD_CHUNK
    nc = L // T
    xc = x.reshape(b, nc, T, H, P)
    Bc = Bh.reshape(b, nc, T, H, N)
    Cc = Ch.reshape(b, nc, T, H, N)
    a_cum = jnp.cumsum(dA.reshape(b, nc, T, H), axis=2)
    a_last = a_cum[:, :, -1]
    states = jnp.einsum('bclhn,bclh,bclhp->bchpn', Bc, jnp.exp(a_last[:, :, None] - a_cum), xc)

    def step(s, inp):
        st, dec = inp
        return s * dec[..., None, None] + st, s

    final, s_in = lax.scan(step, h0, (jnp.moveaxis(states, 1, 0), jnp.moveaxis(jnp.exp(a_last), 1, 0)))
    if not want_y:
        return None, final
    s_in = jnp.moveaxis(s_in, 0, 1)
    seg = a_cum[:, :, :, None, :] - a_cum[:, :, None, :, :]
    lower = jnp.tril(jnp.ones((T, T), dtype=bool))[None, None, :, :, None]
    decay = jnp.exp(jnp.where(lower, seg, -jnp.inf))
    scores = jnp.einsum('bclhn,bcshn->bclsh', Cc, Bc) * decay
    y_diag = jnp.einsum('bclsh,bcshp->bclhp', scores, xc)
    y_off = jnp.einsum('bclhn,bchpn->bclhp', Cc, s_in) * jnp.exp(a_cum)[..., None]
    return (y_diag + y_off).reshape(b, L, H, P), final


def ssd_branch(p_lat, p_ctx, lp, need_ctx):
    f32 = jnp.float32
    rep = SSD_HEADS // SSD_GROUPS

    def prep(p):
        bsz, L, _ = p.shape
        z, xbc, dt_raw = split_cols(p, (BR_W, SSD_CONV_CH, 2 * SSD_HEADS))
        xbc = jax.nn.silu(conv_centred(xbc, lp['ssd_conv_w'], lp['ssd_conv_b']))
        xs, bm, cm = split_cols(xbc, (BR_W, SSD_GN, SSD_GN))
        xs = xs.reshape(bsz, L, SSD_HEADS, SSD_HEAD_DIM).astype(f32)
        bm = jnp.repeat(bm.reshape(bsz, L, SSD_GROUPS, SSD_STATE), rep, axis=2).astype(f32)
        cm = jnp.repeat(cm.reshape(bsz, L, SSD_GROUPS, SSD_STATE), rep, axis=2).astype(f32)
        return z, xs, bm, cm, dt_raw.astype(f32)

    z_l, x_l, b_l, c_l, dt_l = prep(p_lat)
    z_c, x_c, b_c, c_c, dt_c = prep(p_ctx)
    d_skip = lp['ssd_d'].astype(f32)[:, None]
    y_lat = d_skip * x_l
    y_ctx = d_skip * x_c if need_ctx else None
    for d in range(2):
        A = -jnp.exp(lp['ssd_a_log'][d].astype(f32))
        dt_bias = lp['ssd_dt_bias'][d].astype(f32)

        def run(xs, bm, cm, dt_raw, h0, want_y):
            dt = jax.nn.softplus(dt_raw[..., d * SSD_HEADS:(d + 1) * SSD_HEADS] + dt_bias)
            args = (xs * dt[..., None], dt * A, bm, cm)
            if d == 1:
                args = tuple(jnp.flip(t, axis=1) for t in args)
            y, fin = ssd_scan(*args, h0, want_y)
            if d == 1 and y is not None:
                y = jnp.flip(y, axis=1)
            return y, fin

        h0 = jnp.zeros((x_c.shape[0], SSD_HEADS, SSD_HEAD_DIM, SSD_STATE), f32)
        yc, h_ctx_final = run(x_c, b_c, c_c, dt_c, h0, need_ctx)
        if need_ctx:
            y_ctx = y_ctx + yc
        yl, _ = run(x_l, b_l, c_l, dt_l, h_ctx_final, True)
        y_lat = y_lat + yl

    def out(y, z):
        y = y.reshape(z.shape).astype(z.dtype)
        return rms_norm(y * jax.nn.silu(z), lp['ssd_norm_g'])

    return out(y_lat, z_l), (out(y_ctx, z_c) if need_ctx else None)


def mla_qkv(p, lp):
    bsz, L, _ = p.shape
    cq, ckv, k_rope = split_cols(p, (MLA_Q_LORA, MLA_KV_LORA, MLA_ROPE))
    q = (rms_norm(cq, lp['mla_q_a_norm']) @ lp['mla_w_uq']).reshape(bsz, L, MLA_HEADS, MLA_QK)
    kv = (rms_norm(ckv, lp['mla_kv_a_norm']) @ lp['mla_w_ukv']).reshape(bsz, L, MLA_HEADS, MLA_NOPE + MLA_V)
    k_nope, v = jnp.split(kv, [MLA_NOPE], axis=-1)
    k = jnp.concatenate([k_nope, jnp.broadcast_to(k_rope[:, :, None, :], (bsz, L, MLA_HEADS, MLA_ROPE))], axis=-1)
    return rms_norm(q, lp['mla_q_norm']), rms_norm(k, lp['mla_k_norm']), v


def rope_2d(t, cos, sin):
    nope, rot = t[..., :MLA_NOPE], t[..., MLA_NOPE:]
    x1, x2 = jnp.split(rot, 2, axis=-1)
    c = cos[None, :, None, :].astype(t.dtype)
    s = sin[None, :, None, :].astype(t.dtype)
    return jnp.concatenate([nope, x1 * c - x2 * s, x1 * s + x2 * c], axis=-1)


def softmax_attend(q, k, v):
    s = jnp.einsum('bqhd,bkhd->bhqk', q, k).astype(jnp.float32) * (MLA_QK ** -0.5)
    pr = jax.nn.softmax(s, axis=-1).astype(v.dtype)
    return jnp.einsum('bhqk,bkhd->bqhd', pr, v)


def mla_branch(p_lat, p_ctx, cos, sin, lp, need_ctx):
    q_l, k_l, v_l = mla_qkv(p_lat, lp)
    q_c, k_c, v_c = mla_qkv(p_ctx, lp)
    q_l = rope_2d(q_l, cos, sin)
    k_l = rope_2d(k_l, cos, sin)
    k_all = jnp.concatenate([k_c, k_l], axis=1)
    v_all = jnp.concatenate([v_c, v_l], axis=1)
    bsz, L = q_l.shape[0], q_l.shape[1]
    nb = L // ATTN_BLOCK
    qb = jnp.moveaxis(q_l.reshape(bsz, nb, ATTN_BLOCK, MLA_HEADS, MLA_QK), 1, 0)
    ob = lax.map(lambda qq: softmax_attend(qq, k_all, v_all), qb)
    o_lat = jnp.moveaxis(ob, 0, 1).reshape(bsz, L, MLA_HEADS * MLA_V)
    o_ctx = softmax_attend(q_c, k_c, v_c).reshape(bsz, q_c.shape[1], MLA_HEADS * MLA_V) if need_ctx else None
    return o_lat, o_ctx


def gated_merge(ys, gate_cols, w_branch, w_out):
    gates = jax.nn.sigmoid(gate_cols)
    merged = None
    for i, y in enumerate(ys):
        term = gates[..., i * D_MODEL:(i + 1) * D_MODEL] * (y @ w_branch[i])
        merged = term if merged is None else merged + term
    return merged @ w_out


def token_mixing(h_lat, h_ctx, cos, sin, lp, need_ctx):
    p_lat = h_lat @ lp['w_in']
    p_ctx = h_ctx @ lp['w_in']
    s5_l, sgu_l, ssd_l, mla_l, gate_l = split_cols(p_lat, IN_SIZES)
    s5_c, sgu_c, ssd_c, mla_c, gate_c = split_cols(p_ctx, IN_SIZES)
    a_l, a_c = s5_branch(s5_l, s5_c, lp, need_ctx)
    b_l = sgu_branch(sgu_l, lp)
    b_c = sgu_branch(sgu_c, lp) if need_ctx else None
    c_l, c_c = ssd_branch(ssd_l, ssd_c, lp, need_ctx)
    d_l, d_c = mla_branch(mla_l, mla_c, cos, sin, lp, need_ctx)
    out_l = gated_merge((a_l, b_l, c_l, d_l), gate_l, lp['w_branch'], lp['w_out'])
    out_c = gated_merge((a_c, b_c, c_c, d_c), gate_c, lp['w_branch'], lp['w_out']) if need_ctx else None
    return out_l, out_c


def swiglu(h, w_in, w_out):
    g, u = jnp.split(h @ w_in, 2, axis=-1)
    return (jax.nn.silu(g) * u) @ w_out


def setup_inputs(seed: int = 0) -> dict:
    key = jax.random.key(seed)
    ks = iter(jax.random.split(key, 48))
    f32 = jnp.float32

    def nrm(shape, scale):
        return jax.random.normal(next(ks), shape, f32) * scale

    def gain(shape):
        return 1.0 + nrm(shape, 0.05)

    def log_uniform(shape, lo, hi):
        return jax.random.uniform(next(ks), shape, f32, math.log(lo), math.log(hi))

    x = nrm((BATCH, SEQ, D_MODEL), 1.0)
    c = nrm((BATCH, D_MODEL), 1.0)
    ctx = nrm((BATCH, CTX_LEN, D_MODEL), 1.0)
    c_ctx = nrm((D_MODEL,), 1.0)
    w_ada = nrm((DEPTH, D_MODEL, 6 * D_MODEL), 0.5 * D_MODEL ** -0.5)
    b_ada = nrm((DEPTH, 6 * D_MODEL), 0.02)
    norm1_g = gain((DEPTH, D_MODEL))
    norm2_g = gain((DEPTH, D_MODEL))
    w_in = nrm((DEPTH, D_MODEL, IN_W), D_MODEL ** -0.5)
    sg = (DEPTH, 2, S5_GROUPS, S5_STATE)
    s5_a_re = -0.5 + nrm(sg, 0.01)
    s5_a_im = math.pi * jnp.arange(S5_STATE, dtype=f32) + nrm(sg, 0.01)
    s5_b_re = nrm(sg + (S5_GROUP,), (2 * S5_GROUP) ** -0.5)
    s5_b_im = nrm(sg + (S5_GROUP,), (2 * S5_GROUP) ** -0.5)
    s5_c_re = nrm((DEPTH, 2, S5_GROUPS, S5_GROUP, S5_STATE), S5_STATE ** -0.5)
    s5_c_im = nrm((DEPTH, 2, S5_GROUPS, S5_GROUP, S5_STATE), S5_STATE ** -0.5)
    s5_log_dt = log_uniform((DEPTH, 2, S5_GROUPS), S5_DT_MIN, S5_DT_MAX)
    s5_d = nrm((DEPTH, BR_W), 1.0)
    s5_w_glu = nrm((DEPTH, BR_W, BR_W), BR_W ** -0.5)
    sgu_ln_g = gain((DEPTH, BR_W))
    sgu_ln_b = nrm((DEPTH, BR_W), 0.02)
    sgu_w_s = nrm((DEPTH, SGU_HEADS, SGU_CHUNK, SGU_CHUNK), SGU_CHUNK ** -0.5)
    sgu_b_s = 1.0 + nrm((DEPTH, SGU_HEADS, SGU_CHUNK), 0.1)
    ssd_conv_w = nrm((DEPTH, SSD_CONV, SSD_CONV_CH), SSD_CONV ** -0.5)
    ssd_conv_b = nrm((DEPTH, SSD_CONV_CH), 0.02)
    ssd_a_log = jnp.log(jax.random.uniform(next(ks), (DEPTH, 2, SSD_HEADS), f32, 1.0, 16.0))
    dt0 = jnp.exp(log_uniform((DEPTH, 2, SSD_HEADS), SSD_DT_MIN, SSD_DT_MAX))
    ssd_dt_bias = dt0 + jnp.log(-jnp.expm1(-dt0))
    ssd_d = 1.0 + nrm((DEPTH, SSD_HEADS), 0.1)
    ssd_norm_g = gain((DEPTH, BR_W))
    mla_q_a_norm = gain((DEPTH, MLA_Q_LORA))
    mla_w_uq = nrm((DEPTH, MLA_Q_LORA, MLA_HEADS * MLA_QK), MLA_Q_LORA ** -0.5)
    mla_kv_a_norm = gain((DEPTH, MLA_KV_LORA))
    mla_w_ukv = nrm((DEPTH, MLA_KV_LORA, MLA_HEADS * (MLA_NOPE + MLA_V)), MLA_KV_LORA ** -0.5)
    mla_q_norm = gain((DEPTH, MLA_QK))
    mla_k_norm = gain((DEPTH, MLA_QK))
    w_branch = nrm((DEPTH, N_BRANCH, BR_W, D_MODEL), BR_W ** -0.5)
    w_out = nrm((DEPTH, D_MODEL, D_MODEL), D_MODEL ** -0.5)
    w_ffn_in = nrm((DEPTH, D_MODEL, 2 * FFN_HIDDEN), D_MODEL ** -0.5)
    w_ffn_out = nrm((DEPTH, FFN_HIDDEN, D_MODEL), FFN_HIDDEN ** -0.5)
    return {'x': x, 'c': c, 'ctx': ctx, 'c_ctx': c_ctx, 'w_ada': w_ada, 'b_ada': b_ada,
            'norm1_g': norm1_g, 'norm2_g': norm2_g, 'w_in': w_in,
            's5_a_re': s5_a_re, 's5_a_im': s5_a_im, 's5_b_re': s5_b_re, 's5_b_im': s5_b_im,
            's5_c_re': s5_c_re, 's5_c_im': s5_c_im, 's5_log_dt': s5_log_dt, 's5_d': s5_d, 's5_w_glu': s5_w_glu,
            'sgu_ln_g': sgu_ln_g, 'sgu_ln_b': sgu_ln_b, 'sgu_w_s': sgu_w_s, 'sgu_b_s': sgu_b_s,
            'ssd_conv_w': ssd_conv_w, 'ssd_conv_b': ssd_conv_b, 'ssd_a_log': ssd_a_log,
            'ssd_dt_bias': ssd_dt_bias, 'ssd_d': ssd_d, 'ssd_norm_g': ssd_norm_g,
            'mla_q_a_norm': mla_q_a_norm, 'mla_w_uq': mla_w_uq, 'mla_kv_a_norm': mla_kv_a_norm,
            'mla_w_ukv': mla_w_ukv, 'mla_q_norm': mla_q_norm, 'mla_k_norm': mla_k_norm,
            'w_branch': w_branch, 'w_out': w_out, 'w_ffn_in': w_ffn_in, 'w_ffn_out': w_ffn_out}


def reference(x, c, ctx, c_ctx, w_ada, b_ada, norm1_g, norm2_g, w_in,
              s5_a_re, s5_a_im, s5_b_re, s5_b_im, s5_c_re, s5_c_im, s5_log_dt, s5_d, s5_w_glu,
              sgu_ln_g, sgu_ln_b, sgu_w_s, sgu_b_s,
              ssd_conv_w, ssd_conv_b, ssd_a_log, ssd_dt_bias, ssd_d, ssd_norm_g,
              mla_q_a_norm, mla_w_uq, mla_kv_a_norm, mla_w_ukv, mla_q_norm, mla_k_norm,
              w_branch, w_out, w_ffn_in, w_ffn_out):
    f32 = jnp.float32
    L = x.shape[1]
    n_rows = L // GRID_W
    pos_row = jnp.repeat(jnp.arange(n_rows, dtype=f32), GRID_W)
    pos_col = jnp.tile(jnp.arange(GRID_W, dtype=f32), n_rows)
    inv_freq = ROPE_BASE ** (-jnp.arange(ROPE_PAIRS_AXIS, dtype=f32) / ROPE_PAIRS_AXIS)
    ang = jnp.concatenate([pos_row[:, None] * inv_freq, pos_col[:, None] * inv_freq], axis=-1)
    cos, sin = jnp.cos(ang), jnp.sin(ang)

    silu_c = jax.nn.silu(c)
    silu_cc = jax.nn.silu(c_ctx)
    h_ctx_stream = ctx
    for l in range(DEPTH):
        need_ctx = l < DEPTH - 1
        lp = {'w_in': w_in[l],
              's5_a_re': s5_a_re[l], 's5_a_im': s5_a_im[l], 's5_b_re': s5_b_re[l], 's5_b_im': s5_b_im[l],
              's5_c_re': s5_c_re[l], 's5_c_im': s5_c_im[l], 's5_log_dt': s5_log_dt[l], 's5_d': s5_d[l],
              's5_w_glu': s5_w_glu[l],
              'sgu_ln_g': sgu_ln_g[l], 'sgu_ln_b': sgu_ln_b[l], 'sgu_w_s': sgu_w_s[l], 'sgu_b_s': sgu_b_s[l],
              'ssd_conv_w': ssd_conv_w[l], 'ssd_conv_b': ssd_conv_b[l], 'ssd_a_log': ssd_a_log[l],
              'ssd_dt_bias': ssd_dt_bias[l], 'ssd_d': ssd_d[l], 'ssd_norm_g': ssd_norm_g[l],
              'mla_q_a_norm': mla_q_a_norm[l], 'mla_w_uq': mla_w_uq[l], 'mla_kv_a_norm': mla_kv_a_norm[l],
              'mla_w_ukv': mla_w_ukv[l], 'mla_q_norm': mla_q_norm[l], 'mla_k_norm': mla_k_norm[l],
              'w_branch': w_branch[l], 'w_out': w_out[l]}
        mod_l = (silu_c @ w_ada[l] + b_ada[l])[:, None, :]
        mod_c = silu_cc @ w_ada[l] + b_ada[l]
        sh1, sc1, g1, sh2, sc2, g2 = jnp.split(mod_l, 6, axis=-1)
        csh1, csc1, cg1, csh2, csc2, cg2 = jnp.split(mod_c, 6, axis=-1)
        h_lat = modulate(rms_norm(x, norm1_g[l]), sh1, sc1)
        h_ctx = modulate(rms_norm(h_ctx_stream, norm1_g[l]), csh1, csc1)
        mix_lat, mix_ctx = token_mixing(h_lat, h_ctx, cos, sin, lp, need_ctx)
        x = x + g1 * mix_lat
        x = x + g2 * swiglu(modulate(rms_norm(x, norm2_g[l]), sh2, sc2), w_ffn_in[l], w_ffn_out[l])
        if need_ctx:
            h_ctx_stream = h_ctx_stream + cg1 * mix_ctx
            h_ctx_stream = h_ctx_stream + cg2 * swiglu(modulate(rms_norm(h_ctx_stream, norm2_g[l]), csh2, csc2), w_ffn_in[l], w_ffn_out[l])
    return x
```

```cpp
#if defined(__HIP_DEVICE_COMPILE__)
#pragma clang attribute push(__attribute__((target("no-packed-fp32-ops"))), apply_to = function)
#endif
#include <hip/hip_runtime.h>
#include <hip/hip_cooperative_groups.h>
#include <cstdio>
#include <cstdint>
namespace cg = cooperative_groups;

#define NOPK
typedef __bf16 bf16;
using bf16x8 = __attribute__((ext_vector_type(8))) __bf16;
using bf16x4 = __attribute__((ext_vector_type(4))) __bf16;
using f32x16 = __attribute__((ext_vector_type(16))) float;

#define TROWS 16896
#define SEG 8448
#define CTXL 256
#define DM 1024
#define PLD 2944
#define PC_S5 0
#define PC_SGU 384
#define PC_Z 1152
#define PC_XBC 1536
#define PC_DT 2176
#define PC_CQ 2192
#define PC_CKV 2576
#define PC_KR 2832
#define QLD 640
#define KLD 576
#define FFH 2816

#define AL(x) (((x) + 255) & ~(size_t)255)
constexpr size_t OFF_X = 0;
constexpr size_t OFF_H = OFF_X + AL((size_t)TROWS * DM * 4);
constexpr size_t OFF_MG = OFF_H + AL((size_t)TROWS * DM * 2);
constexpr size_t OFF_P = OFF_MG + AL((size_t)TROWS * DM * 2);
constexpr size_t OFF_YB = OFF_P + AL((size_t)TROWS * PLD * 2);
constexpr size_t OFF_Q = OFF_YB + AL((size_t)4 * TROWS * 384 * 2);
constexpr size_t OFF_KF = OFF_Q + AL((size_t)TROWS * QLD * 2);
constexpr size_t OFF_VT = OFF_KF + AL((size_t)TROWS * KLD * 2);
constexpr size_t OFF_YS5 = OFF_VT + AL((size_t)2 * 6 * 64 * SEG * 2);
constexpr size_t OFF_MODP = OFF_YS5 + AL((size_t)TROWS * 384 * 2);
constexpr size_t OFF_MOD = OFF_MODP + AL((size_t)4 * 16 * 3 * 6144 * 4);
constexpr size_t OFF_S5LOC = OFF_MOD + AL((size_t)4 * 3 * 6144 * 4);
constexpr size_t OFF_SSDS = OFF_S5LOC + AL((size_t)2 * 2 * 132 * 24 * 128 * 4);
constexpr size_t OFF_SSDCD = OFF_SSDS + AL((size_t)2 * 2 * 66 * 6 * 4096 * 4);
constexpr size_t OFF_S5BB = OFF_SSDCD + AL((size_t)2 * 2 * 66 * 6 * 4);
constexpr size_t OFF_S5CM = OFF_S5BB + AL((size_t)2 * 24 * 128 * 16 * 2);
constexpr size_t OFF_S5AB = OFF_S5CM + AL((size_t)2 * 24 * 16 * 128 * 2);
constexpr size_t OFF_WIN = OFF_S5AB + AL((size_t)2 * 24 * 64 * 4 * 4);
constexpr size_t OFF_WG = OFF_WIN + AL((size_t)2944 * 1024 * 2);
constexpr size_t OFF_WUQ = OFF_WG + AL((size_t)4096 * 1024 * 2);
constexpr size_t OFF_WUKV = OFF_WUQ + AL((size_t)640 * 384 * 2);
constexpr size_t OFF_WGLU = OFF_WUKV + AL((size_t)768 * 256 * 2);
constexpr size_t OFF_WBR = OFF_WGLU + AL((size_t)384 * 384 * 2);
constexpr size_t OFF_WOUT = OFF_WBR + AL((size_t)4 * 1024 * 384 * 2);
constexpr size_t OFF_WFI = OFF_WOUT + AL((size_t)1024 * 1024 * 2);
constexpr size_t OFF_WFO = OFF_WFI + AL((size_t)5632 * 1024 * 2);
constexpr size_t OFF_WSGU = OFF_WFO + AL((size_t)1024 * 2816 * 2);
constexpr size_t WS_END = OFF_WSGU + AL((size_t)6 * 128 * 128 * 2);
constexpr size_t OFF_HID = OFF_P;
constexpr size_t OFF_CTL = WS_END;
constexpr size_t WS_TOTAL = WS_END + 4096;

#define LDS_BYTES 81920
#define ABL_FFN 0
#define ABL_MIX 0
#ifndef REPEAT_MASK
#define REPEAT_MASK 0
#endif

#define ABL_BR -1

struct Params {
  const float* in[38];
  float* out;
  char* ws;
  int ph_lo, ph_hi;
  int nblk, pad0;
};

__device__ __forceinline__ NOPK int tidx() { int t = __builtin_amdgcn_workitem_id_x(); asm volatile("" : "+v"(t)); return t; }
__device__ __forceinline__ NOPK char* wsp(const Params& p) { char* w = p.ws; asm volatile("" : "+s"(w)); return w; }
__device__ __forceinline__ NOPK float sigm(float x) { return __builtin_amdgcn_rcpf(1.f + __expf(-x)); }
__device__ __forceinline__ NOPK float silu_f(float x) { return x * sigm(x); }
__device__ __forceinline__ NOPK float gelu_f(float x) { return x * sigm(1.5957691216f * (x + 0.044715f * x * x * x)); }
__device__ __forceinline__ NOPK unsigned pack2(float a, float b) {
  union { bf16 h[2]; unsigned u; } P; P.h[0] = (bf16)a; P.h[1] = (bf16)b; return P.u;
}
__device__ __forceinline__ NOPK f32x16 mfma32(bf16x8 a, bf16x8 b, f32x16 c) {
  return __builtin_amdgcn_mfma_f32_32x32x16_bf16(a, b, c, 0, 0, 0);
}
__device__ __forceinline__ NOPK f32x16 zero16() { f32x16 z; for (int i = 0; i < 16; ++i) z[i] = 0.f; asm volatile("" : "+v"(z)); return z; }
__device__ __forceinline__ NOPK float wave_sum(float v) {
  for (int o = 32; o > 0; o >>= 1) v += __shfl_xor(v, o);
  return v;
}

typedef unsigned int u32x4_t __attribute__((ext_vector_type(4)));
typedef __attribute__((address_space(1))) const u32x4_t g_u32x4;
__device__ __forceinline__ NOPK uint4 ldg16(const void* p) {
  u32x4_t v = *(g_u32x4*)p;
  uint4 r; r.x = v.x; r.y = v.y; r.z = v.z; r.w = v.w; return r;
}
template <class T> __device__ __forceinline__ NOPK void gst(T* p, T v) { *(__attribute__((address_space(1))) T*)p = v; }
template <class T> __device__ __forceinline__ NOPK T gld(const T* p) { return *(__attribute__((address_space(1))) const T*)p; }
#define BKK 64
#define LDK 72
template <int NI>
__device__ __forceinline__ NOPK void gemm_core_t(f32x16 (&acc)[2][NI], const bf16* __restrict__ A, int lda,
                                            const bf16* __restrict__ B, int ldb, int K, char* smem) {
  bf16* As = (bf16*)smem;
  bf16* Bs = As + 2 * 128 * LDK;
  const int tid = tidx(), lane = tid & 63, w = tid >> 6, wm = w >> 1, wn = w & 1;
  const int r = lane & 31, h = lane >> 5;
  const int nk = K / BKK;
  const int srow = tid >> 3, spart = tid & 7;
  const bf16* ag = A + (size_t)srow * lda + spart * 8;
  const bf16* bg = B + (size_t)srow * ldb + spart * 8;
  uint4 pa0, pa1, pa2, pa3, pb0, pb1, pb2, pb3;
  uint4 qa0, qa1, qa2, qa3, qb0, qb1, qb2, qb3;
#define GLOAD(S, ko) \
  S##a0 = ldg16(ag + (ko)); S##a1 = ldg16(ag + (size_t)32 * lda + (ko)); \
  S##a2 = ldg16(ag + (size_t)64 * lda + (ko)); S##a3 = ldg16(ag + (size_t)96 * lda + (ko)); \
  S##b0 = ldg16(bg + (ko)); S##b1 = ldg16(bg + (size_t)32 * ldb + (ko)); \
  if (NI == 2) { S##b2 = ldg16(bg + (size_t)64 * ldb + (ko)); S##b3 = ldg16(bg + (size_t)96 * ldb + (ko)); }
#define SSTORE(S, buf) { \
  bf16* asw = As + (buf) * 128 * LDK + srow * LDK + spart * 8; bf16* bsw = Bs + (buf) * 128 * LDK + srow * LDK + spart * 8; \
  *(uint4*)(asw) = S##a0; *(uint4*)(asw + 32 * LDK) = S##a1; *(uint4*)(asw + 64 * LDK) = S##a2; *(uint4*)(asw + 96 * LDK) = S##a3; \
  *(uint4*)(bsw) = S##b0; *(uint4*)(bsw + 32 * LDK) = S##b1; \
  if (NI == 2) { *(uint4*)(bsw + 64 * LDK) = S##b2; *(uint4*)(bsw + 96 * LDK) = S##b3; } }
#define COMPUTE(buf) { \
  const bf16* as = As + (buf) * 128 * LDK + (wm * 64 + r) * LDK + h * 8; \
  const bf16* bs = Bs + (buf) * 128 * LDK + (wn * 32 * NI + r) * LDK + h * 8; \
  _Pragma("unroll") for (int ks = 0; ks < BKK / 16; ++ks) { \
    bf16x8 a0 = *(const bf16x8*)(as + ks * 16); bf16x8 a1 = *(const bf16x8*)(as + 32 * LDK + ks * 16); \
    _Pragma("unroll") for (int ni = 0; ni < NI; ++ni) { \
      bf16x8 b0 = *(const bf16x8*)(bs + ni * 32 * LDK + ks * 16); \
      acc[0][ni] = mfma32(a0, b0, acc[0][ni]); acc[1][ni] = mfma32(a1, b0, acc[1][ni]); } } }
  GLOAD(p, 0)
  GLOAD(q, BKK)
  for (int kt = 0; kt < nk; kt += 2) {
    SSTORE(p, 0)
    __syncthreads();
    if (kt + 2 < nk) { GLOAD(p, (kt + 2) * BKK) }
    COMPUTE(0)
    SSTORE(q, 1)
    __syncthreads();
    if (kt + 3 < nk) { GLOAD(q, (kt + 3) * BKK) }
    COMPUTE(1)
  }
  __syncthreads();
#undef GLOAD
#undef SSTORE
#undef COMPUTE
}
__device__ __forceinline__ NOPK void gemm_core(f32x16 (&acc)[2][2], const bf16* __restrict__ A, int lda,
                                          const bf16* __restrict__ B, int ldb, int K, char* smem) {
  gemm_core_t<2>(acc, A, lda, B, ldb, K, smem);
}
#define LDK2 40
__device__ __forceinline__ NOPK void gemm_core_big(f32x16 (&acc)[4][2], const bf16* __restrict__ A, int lda,
                                                   const bf16* __restrict__ B, int ldb, int K, char* smem) {
  bf16* As = (bf16*)smem;
  bf16* Bs = As + 2 * 256 * LDK2;
  const int tid = tidx(), lane = tid & 63, w = tid >> 6, wm = w >> 1, wn = w & 1;
  const int r = lane & 31, h = lane >> 5;
  const int nk = K / 32;
  const int srow = tid >> 2, spart = tid & 3;
  const bf16* ag = A + (size_t)srow * lda + spart * 8;
  const bf16* bg = B + (size_t)srow * ldb + spart * 8;
  uint4 pa0, pa1, pa2, pa3, pb0, pb1;
  uint4 qa0, qa1, qa2, qa3, qb0, qb1;
#define GLOAD(S, ko) \
  S##a0 = ldg16(ag + (ko)); S##a1 = ldg16(ag + (size_t)64 * lda + (ko)); \
  S##a2 = ldg16(ag + (size_t)128 * lda + (ko)); S##a3 = ldg16(ag + (size_t)192 * lda + (ko)); \
  S##b0 = ldg16(bg + (ko)); S##b1 = ldg16(bg + (size_t)64 * ldb + (ko));
#define SSTORE(S, buf) { \
  bf16* asw = As + (buf) * 256 * LDK2 + srow * LDK2 + spart * 8; bf16* bsw = Bs + (buf) * 128 * LDK2 + srow * LDK2 + spart * 8; \
  *(uint4*)(asw) = S##a0; *(uint4*)(asw + 64 * LDK2) = S##a1; *(uint4*)(asw + 128 * LDK2) = S##a2; *(uint4*)(asw + 192 * LDK2) = S##a3; \
  *(uint4*)(bsw) = S##b0; *(uint4*)(bsw + 64 * LDK2) = S##b1; }
#define COMPUTE(buf) { \
  const bf16* as = As + (buf) * 256 * LDK2 + (wm * 128 + r) * LDK2 + h * 8; \
  const bf16* bs = Bs + (buf) * 128 * LDK2 + (wn * 64 + r) * LDK2 + h * 8; \
  _Pragma("unroll") for (int ks = 0; ks < 2; ++ks) { \
    bf16x8 b0 = *(const bf16x8*)(bs + ks * 16); bf16x8 b1 = *(const bf16x8*)(bs + 32 * LDK2 + ks * 16); \
    _Pragma("unroll") for (int mi = 0; mi < 4; ++mi) { \
      bf16x8 a = *(const bf16x8*)(as + mi * 32 * LDK2 + ks * 16); \
      acc[mi][0] = mfma32(a, b0, acc[mi][0]); acc[mi][1] = mfma32(a, b1, acc[mi][1]); } } }
  GLOAD(p, 0)
  GLOAD(q, 32)
  for (int kt = 0; kt < nk; kt += 2) {
    SSTORE(p, 0)
    __syncthreads();
    if (kt + 2 < nk) { GLOAD(p, (kt + 2) * 32) }
    COMPUTE(0)
    SSTORE(q, 1)
    __syncthreads();
    if (kt + 3 < nk) { GLOAD(q, (kt + 3) * 32) }
    COMPUTE(1)
  }
  __syncthreads();
#undef GLOAD
#undef SSTORE
#undef COMPUTE
}
struct Stage6 { uint4 a0, a1, a2, a3, b0, b1; };
__device__ __forceinline__ NOPK void chain_load(Stage6& s, const bf16* ag, int lda, const bf16* bg, int ldb, int ko) {
  s.a0 = ldg16(ag + ko); s.a1 = ldg16(ag + (size_t)32 * lda + ko); s.a2 = ldg16(ag + (size_t)64 * lda + ko); s.a3 = ldg16(ag + (size_t)96 * lda + ko);
  s.b0 = ldg16(bg + ko); s.b1 = ldg16(bg + (size_t)32 * ldb + ko);
}
__device__ __forceinline__ NOPK void gemm_chain(f32x16 (&acc)[2][1], Stage6& P, Stage6& Q, const bf16* __restrict__ A, int lda,
                                                const bf16* __restrict__ B, int ldb, int K, const bf16* __restrict__ nA, int nlda,
                                                const bf16* __restrict__ nB, int nldb, char* smem) {
  bf16* As = (bf16*)smem;
  bf16* Bs = As + 2 * 128 * LDK;
  const int tid = tidx(), lane = tid & 63, w = tid >> 6, wm = w >> 1, wn = w & 1;
  const int r = lane & 31, h = lane >> 5;
  const int nk = K / BKK;
  const int srow = tid >> 3, spart = tid & 7;
  const bf16* ag = A + (size_t)srow * lda + spart * 8;
  const bf16* bg = B + (size_t)srow * ldb + spart * 8;
  const bf16* nag = nA + (size_t)srow * nlda + spart * 8;
  const bf16* nbg = nB + (size_t)srow * nldb + spart * 8;
#define CSTORE(S, buf) { \
  bf16* asw = As + (buf) * 128 * LDK + srow * LDK + spart * 8; bf16* bsw = Bs + (buf) * 128 * LDK + srow * LDK + spart * 8; \
  *(uint4*)(asw) = S.a0; *(uint4*)(asw + 32 * LDK) = S.a1; *(uint4*)(asw + 64 * LDK) = S.a2; *(uint4*)(asw + 96 * LDK) = S.a3; \
  *(uint4*)(bsw) = S.b0; *(uint4*)(bsw + 32 * LDK) = S.b1; }
#define CCOMPUTE(buf) { \
  const bf16* as = As + (buf) * 128 * LDK + (wm * 64 + r) * LDK + h * 8; \
  const bf16* bs = Bs + (buf) * 128 * LDK + (wn * 32 + r) * LDK + h * 8; \
  _Pragma("unroll") for (int ks = 0; ks < BKK / 16; ++ks) { \
    bf16x8 a0 = *(const bf16x8*)(as + ks * 16); bf16x8 a1 = *(const bf16x8*)(as + 32 * LDK + ks * 16); \
    bf16x8 b0 = *(const bf16x8*)(bs + ks * 16); \
    acc[0][0] = mfma32(a0, b0, acc[0][0]); acc[1][0] = mfma32(a1, b0, acc[1][0]); } }
  for (int kt = 0; kt < nk; kt += 2) {
    CSTORE(P, 0)
    __syncthreads();
    if (kt + 2 < nk) chain_load(P, ag, lda, bg, ldb, (kt + 2) * BKK);
    else if (nA) chain_load(P, nag, nlda, nbg, nldb, 0);
    CCOMPUTE(0)
    CSTORE(Q, 1)
    __syncthreads();
    if (kt + 3 < nk) chain_load(Q, ag, lda, bg, ldb, (kt + 3) * BKK);
    else if (nA) chain_load(Q, nag, nlda, nbg, nldb, BKK);
    CCOMPUTE(1)
  }
  __syncthreads();
#undef CSTORE
#undef CCOMPUTE
}

template <class F>
__device__ __forceinline__ NOPK void gemm_epi(const f32x16 (&acc)[2][2], F f) {
  const int lane = tidx() & 63, w = tidx() >> 6, wm = w >> 1, wn = w & 1, r = lane & 31, h = lane >> 5;
#pragma unroll
  for (int mi = 0; mi < 2; ++mi)
#pragma unroll
    for (int ni = 0; ni < 2; ++ni)
#pragma unroll
      for (int reg = 0; reg < 16; ++reg) {
        int row = wm * 64 + mi * 32 + (reg & 3) + 8 * (reg >> 2) + 4 * h;
        int col = wn * 64 + ni * 32 + r;
        f(row, col, acc[mi][ni][reg]);
      }
}
__device__ __forceinline__ NOPK void zero_acc(f32x16 (&acc)[2][2]) {
  acc[0][0] = zero16(); acc[0][1] = zero16(); acc[1][0] = zero16(); acc[1][1] = zero16();
}

template <class CM>
__device__ __forceinline__ NOPK void conv_tile(const float* __restrict__ src, int ld, int k0, int n0, bf16* __restrict__ dst, int dstld,
                                          const float* __restrict__ kscale, CM cmap, float* lds) {
  const int tid = tidx();
  {
    const int nn = tid & 63;
    const int sc = cmap(n0 + nn);
#pragma unroll 4
    for (int i = 0; i < 16; ++i) {
      int kk = (tid >> 6) + 4 * i;
      float v = sc >= 0 ? src[(size_t)(k0 + kk) * ld + sc] : 0.f;
      if (kscale) v *= kscale[k0 + kk];
      lds[kk * 65 + nn] = v;
    }
  }
  __syncthreads();
  {
    const int kk2 = (tid & 31) * 2;
#pragma unroll 4
    for (int i = 0; i < 8; ++i) {
      int nn = (tid >> 5) + 8 * i;
      unsigned u = pack2(lds[kk2 * 65 + nn], lds[(kk2 + 1) * 65 + nn]);
      *(unsigned*)(dst + (size_t)(n0 + nn) * dstld + k0 + kk2) = u;
    }
  }
  __syncthreads();
}

__device__ NOPK void wprep_item(const Params& p, int l, int it, char* smem) {
  float* lds = (float*)smem;
  char* ws = wsp(p);
  constexpr int T_WIN = 46 * 16, T_WG = 64 * 16, T_WUQ = 10 * 6, T_WUKV = 12 * 4, T_WGLU = 6 * 6, T_WBR = 4 * 16 * 6,
                T_WOUT = 16 * 16, T_WFI = 88 * 16, T_WFO = 16 * 44;
  if (it < T_WIN) {
    int nt = it / 16, kt = it % 16;
    conv_tile(p.in[8] + (size_t)l * 1024 * 6956, 6956, kt * 64, nt * 64, (bf16*)(ws + OFF_WIN), 1024, nullptr,
              [](int n) NOPK { return n < 2188 ? n : (n < 2192 ? -1 : (n < 2864 ? n - 4 : -1)); }, lds);
    return;
  }
  it -= T_WIN;
  if (it < T_WG) {
    int nt = it / 16, kt = it % 16;
    conv_tile(p.in[8] + (size_t)l * 1024 * 6956, 6956, kt * 64, nt * 64, (bf16*)(ws + OFF_WG), 1024, nullptr,
              [](int n) NOPK { return 2860 + n; }, lds);
    return;
  }
  it -= T_WG;
  if (it < T_WUQ) {
    int nt = it / 6, kt = it % 6;
    conv_tile(p.in[29] + (size_t)l * 384 * 576, 576, kt * 64, nt * 64, (bf16*)(ws + OFF_WUQ), 384, p.in[28] + l * 384,
              [](int n) NOPK { return n < 576 ? n : -1; }, lds);
    return;
  }
  it -= T_WUQ;
  if (it < T_WUKV) {
    int nt = it / 4, kt = it % 4;
    conv_tile(p.in[31] + (size_t)l * 256 * 768, 768, kt * 64, nt * 64, (bf16*)(ws + OFF_WUKV), 256, p.in[30] + l * 256,
              [](int n) NOPK { return n; }, lds);
    return;
  }
  it -= T_WUKV;
  if (it < T_WGLU) {
    int nt = it / 6, kt = it % 6;
    conv_tile(p.in[17] + (size_t)l * 384 * 384, 384, kt * 64, nt * 64, (bf16*)(ws + OFF_WGLU), 384, nullptr,
              [](int n) NOPK { return n; }, lds);
    return;
  }
  it -= T_WGLU;
  if (it < T_WBR) {
    int br = it / 96, rem = it % 96, nt = rem / 6, kt = rem % 6;
    conv_tile(p.in[34] + ((size_t)l * 4 + br) * 384 * 1024, 1024, kt * 64, nt * 64, (bf16*)(ws + OFF_WBR) + (size_t)br * 1024 * 384, 384,
              br == 2 ? p.in[27] + l * 384 : nullptr, [](int n) NOPK { return n; }, lds);
    return;
  }
  it -= T_WBR;
  if (it < T_WOUT) {
    int nt = it / 16, kt = it % 16;
    conv_tile(p.in[35] + (size_t)l * 1024 * 1024, 1024, kt * 64, nt * 64, (bf16*)(ws + OFF_WOUT), 1024, nullptr,
              [](int n) NOPK { return n; }, lds);
    return;
  }
  it -= T_WOUT;
  if (it < T_WFI) {
    int nt = it / 16, kt = it % 16;
    conv_tile(p.in[36] + (size_t)l * 1024 * 5632, 5632, kt * 64, nt * 64, (bf16*)(ws + OFF_WFI), 1024, nullptr,
              [](int n) NOPK { int tile = n >> 7, wn = (n >> 6) & 1, sub = (n >> 5) & 1, c = n & 31; return sub * FFH + tile * 64 + wn * 32 + c; }, lds);
    return;
  }
  it -= T_WFI;
  if (it < T_WFO) {
    int nt = it / 44, kt = it % 44;
    conv_tile(p.in[37] + (size_t)l * FFH * 1024, 1024, kt * 64, nt * 64, (bf16*)(ws + OFF_WFO), FFH, nullptr,
              [](int n) NOPK { return n; }, lds);
    return;
  }
  it -= T_WFO;
  if (it < 96) {
    const float* src = p.in[20] + (size_t)l * 6 * 128 * 128;
    bf16* dst = (bf16*)(ws + OFF_WSGU);
    int base = it * 1024 + tidx() * 4;
    float4 v = *(const float4*)(src + base);
    uint2 u; u.x = pack2(v.x, v.y); u.y = pack2(v.z, v.w);
    *(uint2*)(dst + base) = u;
    return;
  }
  it -= 96;
  if (it < 48) {
    int d = it / 24, g = it % 24;
    int pp = tidx() & 63, part = tidx() >> 6;
    size_t sg = (((size_t)l * 2 + d) * 24 + g) * 64 + pp;
    float a_re = p.in[9][sg], a_im = p.in[10][sg];
    float dt = expf(p.in[15][((size_t)l * 2 + d) * 24 + g]);
    float mag = expf(a_re * dt), ang = a_im * dt;
    float ab_re = mag * cosf(ang), ab_im = mag * sinf(ang);
    float den = a_re * a_re + a_im * a_im;
    float f_re = ((ab_re - 1.f) * a_re + ab_im * a_im) / den;
    float f_im = (ab_im * a_re - (ab_re - 1.f) * a_im) / den;
    bf16* bb = (bf16*)(ws + OFF_S5BB) + (size_t)(d * 24 + g) * 128 * 16;
    bf16* cm = (bf16*)(ws + OFF_S5CM) + (size_t)(d * 24 + g) * 16 * 128;
    for (int c = part * 4; c < part * 4 + 4; ++c) {
      float b_re = p.in[11][sg * 16 + c], b_im = p.in[12][sg * 16 + c];
      bb[pp * 16 + c] = (bf16)(f_re * b_re - f_im * b_im);
      bb[(64 + pp) * 16 + c] = (bf16)(f_re * b_im + f_im * b_re);
      size_t ci = ((((size_t)l * 2 + d) * 24 + g) * 16 + c) * 64 + pp;
      cm[c * 128 + pp] = (bf16)(p.in[13][ci]);
      cm[c * 128 + 64 + pp] = (bf16)(-p.in[14][ci]);
    }
    if (part == 0) {
      float wr = ab_re, wi = ab_im;
      for (int s = 0; s < 6; ++s) { float nr = wr * wr - wi * wi, ni = 2.f * wr * wi; wr = nr; wi = ni; }
      float4 o; o.x = ab_re; o.y = ab_im; o.z = wr; o.w = wi;
      ((float4*)(ws + OFF_S5AB))[(d * 24 + g) * 64 + pp] = o;
    }
    return;
  }
}
#define WPREP_ITEMS (46 * 16 + 64 * 16 + 60 + 48 + 36 + 384 + 256 + 88 * 16 + 16 * 44 + 96 + 48)

__device__ NOPK void norm_item(const Params& p, int l, int which, int item) {
  const int w = tidx() >> 6, lane = tidx() & 63;
  const int row = item * 4 + w;
  const int b = row / SEG, j = row % SEG;
  const int v = j < CTXL ? 2 : b;
  const float* x = (const float*)(wsp(p) + OFF_X) + (size_t)row * DM;
  const float* g = p.in[which ? 7 : 6] + l * DM;
  const float* mod = (const float*)(wsp(p) + OFF_MOD) + (size_t)(l * 3 + v) * 6144 + which * 3072;
  float4 xv[4];
  float ss = 0.f;
#pragma unroll
  for (int i = 0; i < 4; ++i) {
    xv[i] = ((const float4*)x)[lane + 64 * i];
    ss += xv[i].x * xv[i].x + xv[i].y * xv[i].y + xv[i].z * xv[i].z + xv[i].w * xv[i].w;
  }
  ss = wave_sum(ss);
  const float rinv = rsqrtf(ss * (1.f / 1024.f) + 1e-6f);
  bf16* hout = (bf16*)(wsp(p) + OFF_H) + (size_t)row * DM;
#pragma unroll
  for (int i = 0; i < 4; ++i) {
    int k = (lane + 64 * i) * 4;
    float4 gv = *(const float4*)(g + k), sh = *(const float4*)(mod + k), sc = *(const float4*)(mod + 1024 + k);
    float y0 = xv[i].x * rinv * gv.x * (1.f + sc.x) + sh.x;
    float y1 = xv[i].y * rinv * gv.y * (1.f + sc.y) + sh.y;
    float y2 = xv[i].z * rinv * gv.z * (1.f + sc.z) + sh.z;
    float y3 = xv[i].w * rinv * gv.w * (1.f + sc.w) + sh.w;
    uint2 u; u.x = pack2(y0, y1); u.y = pack2(y2, y3);
    *(uint2*)(hout + k) = u;
  }
}

__device__ __forceinline__ NOPK void row_rms(const bf16* base, int ld, int ncols, float eps, float* rs) {
  const int row = tidx() >> 1, half = tidx() & 1;
  const int per = ncols / 2;
  const bf16* src = base + (size_t)row * ld + half * per;
  float ss = 0.f;
#pragma unroll 8
  for (int i = 0; i < per; i += 8) {
    bf16x8 v = *(const bf16x8*)(src + i);
#pragma unroll
    for (int e = 0; e < 8; ++e) { float f = (float)v[e]; ss += f * f; }
  }
  ss += __shfl_xor(ss, 1);
  if (half == 0) rs[row] = rsqrtf(ss / (float)ncols + eps);
  __syncthreads();
}

__device__ NOPK void sgu_item(const Params& p, int l, int item, char* smem) {
  const int head = item % 6, c = (item / 6) % 66, b = item / 396;
  const int R0 = b * SEG + c * 128;
  const bf16* P = (const bf16*)(wsp(p) + OFF_P);
  bf16* vnT = (bf16*)smem;
  float* mu = (float*)(smem + 64 * 136 * 2);
  float* rstd = mu + 128;
  const int tid = tidx();
  {
    const int row = tid >> 1, half = tid & 1;
    const bf16* src = P + (size_t)(R0 + row) * PLD + PC_SGU + 384 + half * 192;
    float s1 = 0.f, s2 = 0.f;
#pragma unroll 8
    for (int i = 0; i < 192; i += 8) {
      bf16x8 v = *(const bf16x8*)(src + i);
#pragma unroll
      for (int e = 0; e < 8; ++e) { float f = gelu_f((float)v[e]); s1 += f; s2 += f * f; }
    }
    s1 += __shfl_xor(s1, 1); s2 += __shfl_xor(s2, 1);
    float m = s1 * (1.f / 384.f);
    float var = s2 * (1.f / 384.f) - m * m;
    if (half == 0) { mu[row] = m; rstd[row] = rsqrtf(fmaxf(var, 0.f) + 1e-5f); }
  }
  __syncthreads();
  {
    const int row = tid >> 1, half = tid & 1;
    const bf16* src = P + (size_t)(R0 + row) * PLD + PC_SGU + 384 + head * 64 + half * 32;
    const float* lg = p.in[18] + l * 384 + head * 64 + half * 32;
    const float* lb = p.in[19] + l * 384 + head * 64 + half * 32;
    const float m = mu[row], rs = rstd[row];
#pragma unroll
    for (int i = 0; i < 32; i += 8) {
      bf16x8 v = *(const bf16x8*)(src + i);
#pragma unroll
      for (int e = 0; e < 8; ++e) {
        float f = (gelu_f((float)v[e]) - m) * rs * lg[i + e] + lb[i + e];
        vnT[(half * 32 + i + e) * 136 + row] = (bf16)f;
      }
    }
  }
  __syncthreads();
  const int lane = tid & 63, w = tid >> 6, r = lane & 31, h = lane >> 5;
  f32x16 acc[2] = {zero16(), zero16()};
  const bf16* Ws = (const bf16*)(wsp(p) + OFF_WSGU) + (size_t)head * 128 * 128 + (size_t)(32 * w + r) * 128 + 8 * h;
#pragma unroll
  for (int ks = 0; ks < 8; ++ks) {
    bf16x8 a = *(const bf16x8*)(Ws + 16 * ks);
    bf16x8 b0 = *(const bf16x8*)(vnT + r * 136 + 16 * ks + 8 * h);
    bf16x8 b1 = *(const bf16x8*)(vnT + (32 + r) * 136 + 16 * ks + 8 * h);
    acc[0] = mfma32(a, b0, acc[0]);
    acc[1] = mfma32(a, b1, acc[1]);
  }
  const float* bsp = p.in[21] + ((size_t)l * 6 + head) * 128;
  bf16* yo = (bf16*)(wsp(p) + OFF_YB) + (size_t)1 * TROWS * 384;
#pragma unroll
  for (int dt = 0; dt < 2; ++dt)
#pragma unroll
    for (int reg = 0; reg < 16; ++reg) {
      int t = 32 * w + (reg & 3) + 8 * (reg >> 2) + 4 * h;
      int d = 32 * dt + r;
      float mixed = acc[dt][reg] + bsp[t];
      float u = gelu_f((float)P[(size_t)(R0 + t) * PLD + PC_SGU + head * 64 + d]);
      yo[(size_t)(R0 + t) * 384 + head * 64 + d] = (bf16)(u * mixed);
    }
  __syncthreads();
}

__device__ __forceinline__ NOPK void s5_wave(const Params& p, int b, int kk, int d, int g, bf16* hl, float& sre, float& sim, bool writeH) {
  const int lane = tidx() & 63, r = lane & 31, h = lane >> 5;
  const int R0 = b * SEG + kk * 64;
  const bf16* P = (const bf16*)(wsp(p) + OFF_P);
  const bf16* bb = (const bf16*)(wsp(p) + OFF_S5BB) + (size_t)(d * 24 + g) * 128 * 16;
#pragma unroll
  for (int mt = 0; mt < 2; ++mt) {
    bf16x8 a = *(const bf16x8*)(P + (size_t)(R0 + 32 * mt + r) * PLD + PC_S5 + g * 16 + 8 * h);
#pragma unroll
    for (int nt = 0; nt < 4; ++nt) {
      bf16x8 bv = *(const bf16x8*)(bb + (32 * nt + r) * 16 + 8 * h);
      f32x16 acc = mfma32(a, bv, zero16());
#pragma unroll
      for (int reg = 0; reg < 16; ++reg) {
        int t = 32 * mt + (reg & 3) + 8 * (reg >> 2) + 4 * h;
        hl[t * 136 + 32 * nt + r] = (bf16)acc[reg];
      }
    }
  }
  asm volatile("s_waitcnt lgkmcnt(0)" ::: "memory");
  const float4 ab = ((const float4*)(wsp(p) + OFF_S5AB))[(d * 24 + g) * 64 + lane];
#pragma unroll 1
  for (int s0 = 0; s0 < 64; s0 += 8) {
    bf16 vr[8], vi[8];
#pragma unroll
    for (int j = 0; j < 8; ++j) {
      int t = d ? 63 - (s0 + j) : s0 + j;
      vr[j] = hl[t * 136 + lane]; vi[j] = hl[t * 136 + 64 + lane];
    }
#pragma unroll
    for (int j = 0; j < 8; ++j) {
      int t = d ? 63 - (s0 + j) : s0 + j;
      float nre = ab.x * sre - ab.y * sim + (float)vr[j];
      float nim = ab.x * sim + ab.y * sre + (float)vi[j];
      sre = nre; sim = nim;
      if (writeH) { hl[t * 136 + lane] = (bf16)sre; hl[t * 136 + 64 + lane] = (bf16)sim; }
    }
  }
  asm volatile("s_waitcnt lgkmcnt(0)" ::: "memory");
}
__device__ NOPK void s5a_item(const Params& p, int item, char* smem) {
  const int quad = item % 6, d = (item / 6) & 1, kk = (item / 12) % 132, b = item / (12 * 132);
  const int w = tidx() >> 6, lane = tidx() & 63;
  const int g = quad * 4 + w;
  bf16* hl = (bf16*)smem + w * 64 * 136;
  float sre = 0.f, sim = 0.f;
  s5_wave(p, b, kk, d, g, hl, sre, sim, false);
  float2* loc = (float2*)(wsp(p) + OFF_S5LOC);
  loc[((size_t)((b * 2 + d) * 132 + kk) * 24 + g) * 64 + lane] = make_float2(sre, sim);
  __syncthreads();
}
__device__ NOPK void s5b_item(const Params& p, int l, int item, char* smem) {
  const int quad = item % 6, kk = (item / 6) % 132, b = item / (6 * 132);
  const int w = tidx() >> 6, lane = tidx() & 63, r = lane & 31, h = lane >> 5;
  const int g = quad * 4 + w;
  bf16* hl = (bf16*)smem + w * 64 * 136;
  const float2* loc = (const float2*)(wsp(p) + OFF_S5LOC);
  f32x16 yacc[2] = {zero16(), zero16()};
  for (int d = 0; d < 2; ++d) {
    const float4 ab = ((const float4*)(wsp(p) + OFF_S5AB))[(d * 24 + g) * 64 + lane];
    float sre = 0.f, sim = 0.f;
    const int npos = d ? (kk < 4 ? 3 - kk : 135 - kk) : kk;
    const float2* locb = loc + ((size_t)((b * 2 + d) * 132) * 24 + g) * 64 + lane;
    int o = 0;
    for (; o + 16 <= npos; o += 16) {
      float2 s0, s1, s2, s3, s4, s5, s6, s7, t0, t1, t2, t3, t4, t5, t6, t7;
#define LOCLD(j) locb[(size_t)(d ? ((o + j) < 4 ? 3 - (o + j) : 135 - (o + j)) : (o + j)) * 24 * 64]
#define CSTEP(s) { float nre = ab.z * sre - ab.w * sim + s.x; float nim = ab.z * sim + ab.w * sre + s.y; sre = nre; sim = nim; }
      s0 = LOCLD(0); s1 = LOCLD(1); s2 = LOCLD(2); s3 = LOCLD(3); s4 = LOCLD(4); s5 = LOCLD(5); s6 = LOCLD(6); s7 = LOCLD(7);
      t0 = LOCLD(8); t1 = LOCLD(9); t2 = LOCLD(10); t3 = LOCLD(11); t4 = LOCLD(12); t5 = LOCLD(13); t6 = LOCLD(14); t7 = LOCLD(15);
      CSTEP(s0) CSTEP(s1) CSTEP(s2) CSTEP(s3) CSTEP(s4) CSTEP(s5) CSTEP(s6) CSTEP(s7)
      CSTEP(t0) CSTEP(t1) CSTEP(t2) CSTEP(t3) CSTEP(t4) CSTEP(t5) CSTEP(t6) CSTEP(t7)
#undef LOCLD
#undef CSTEP
    }
    for (; o + 8 <= npos; o += 8) {
      float2 s0, s1, s2, s3, s4, s5, s6, s7;
#define LOCLD(j) locb[(size_t)(d ? ((o + j) < 4 ? 3 - (o + j) : 135 - (o + j)) : (o + j)) * 24 * 64]
      s0 = LOCLD(0); s1 = LOCLD(1); s2 = LOCLD(2); s3 = LOCLD(3); s4 = LOCLD(4); s5 = LOCLD(5); s6 = LOCLD(6); s7 = LOCLD(7);
#define CSTEP(s) { float nre = ab.z * sre - ab.w * sim + s.x; float nim = ab.z * sim + ab.w * sre + s.y; sre = nre; sim = nim; }
      CSTEP(s0) CSTEP(s1) CSTEP(s2) CSTEP(s3) CSTEP(s4) CSTEP(s5) CSTEP(s6) CSTEP(s7)
    }
    for (; o < npos; ++o) {
      float2 s = LOCLD(0);
      CSTEP(s)
    }
#undef LOCLD
#undef CSTEP
    s5_wave(p, b, kk, d, g, hl, sre, sim, true);
    const bf16* cm = (const bf16*)(wsp(p) + OFF_S5CM) + (size_t)(d * 24 + g) * 16 * 128;
#pragma unroll
    for (int ks = 0; ks < 8; ++ks) {
      bf16x8 bv;
#pragma unroll
      for (int e = 0; e < 8; ++e) bv[e] = (bf16)0.f;
      if (r < 16) bv = *(const bf16x8*)(cm + r * 128 + 16 * ks + 8 * h);
      bf16x8 a0 = *(const bf16x8*)(hl + r * 136 + 16 * ks + 8 * h);
      bf16x8 a1 = *(const bf16x8*)(hl + (32 + r) * 136 + 16 * ks + 8 * h);
      yacc[0] = mfma32(a0, bv, yacc[0]);
      yacc[1] = mfma32(a1, bv, yacc[1]);
    }
    asm volatile("s_waitcnt lgkmcnt(0)" ::: "memory");
  }
  if (r < 16) {
    const int R0 = b * SEG + kk * 64;
    const bf16* P = (const bf16*)(wsp(p) + OFF_P);
    bf16* ys = (bf16*)(wsp(p) + OFF_YS5);
    const int ch = g * 16 + r;
    const float dsk = p.in[16][l * 384 + ch];
#pragma unroll
    for (int mt = 0; mt < 2; ++mt)
#pragma unroll
      for (int reg = 0; reg < 16; ++reg) {
        int t = 32 * mt + (reg & 3) + 8 * (reg >> 2) + 4 * h;
        float u = (float)P[(size_t)(R0 + t) * PLD + PC_S5 + ch];
        float y = yacc[mt][reg] + dsk * u;
        ys[(size_t)(R0 + t) * 384 + ch] = (bf16)gelu_f(y);
      }
  }
  __syncthreads();
}

__device__ __forceinline__ NOPK void ssd_dt(const Params& p, int l, int R0, int hh, float* dts, float* das, float* acs) {
  const int tid = tidx();
  const bf16* P = (const bf16*)(wsp(p) + OFF_P);
  {
    int t = tid & 127, d = tid >> 7;
    float raw = (float)P[(size_t)(R0 + t) * PLD + PC_DT + d * 6 + hh] + p.in[25][(l * 2 + d) * 6 + hh];
    float dt = raw > 20.f ? raw : log1pf(expf(raw));
    float A = -expf(p.in[24][(l * 2 + d) * 6 + hh]);
    dts[d * 128 + t] = dt;
    das[d * 128 + t] = dt * A;
  }
  __syncthreads();
  if (tid < 128) {
    int d = tid >> 6, lane = tid & 63;
    float a0 = das[d * 128 + 2 * lane], a1 = das[d * 128 + 2 * lane + 1];
    float s = a0 + a1;
    for (int o = 1; o < 64; o <<= 1) { float n = __shfl_up(s, o); if (lane >= o) s += n; }
    acs[d * 128 + 2 * lane + 1] = s;
    acs[d * 128 + 2 * lane] = s - a1;
  }
  __syncthreads();
}
__device__ __forceinline__ NOPK void ssd_load_tile(const Params& p, int l, int R0, int ch0, bf16* dst, int stride, bool transposed) {
  const bf16* P = (const bf16*)(wsp(p) + OFF_P);
  const float* cw = p.in[22] + (size_t)l * 3 * 640;
  const float* cb = p.in[23] + (size_t)l * 640;
#pragma unroll
  for (int it = 0; it < 4; ++it) {
    int idx = tidx() + 256 * it;
    int t = idx >> 3, cgp = idx & 7;
    int ch = ch0 + cgp * 8;
    int row = R0 + t, j = row % SEG;
    bool hp = (j != 0) && (j != CTXL), hn = (j != CTXL - 1) && (j != SEG - 1);
    const bf16* src = P + (size_t)row * PLD + PC_XBC + ch;
    bf16x8 cur = *(const bf16x8*)src, prv, nxt;
#pragma unroll
    for (int e = 0; e < 8; ++e) { prv[e] = (bf16)0.f; nxt[e] = (bf16)0.f; }
    if (hp) prv = *(const bf16x8*)(src - PLD);
    if (hn) nxt = *(const bf16x8*)(src + PLD);
    bf16x8 o;
#pragma unroll
    for (int e = 0; e < 8; ++e) {
      float v = cw[ch + e] * (float)prv[e] + cw[640 + ch + e] * (float)cur[e] + cw[1280 + ch + e] * (float)nxt[e] + cb[ch + e];
      o[e] = (bf16)silu_f(v);
    }
    if (transposed) {
#pragma unroll
      for (int e = 0; e < 8; ++e) dst[(cgp * 8 + e) * stride + t] = o[e];
    } else {
      *(bf16x8*)(dst + t * stride + cgp * 8) = o;
    }
  }
}
__device__ NOPK void ssda_item(const Params& p, int l, int item, char* smem) {
  const int hh = item % 6, c = (item / 6) % 66, b = item / 396;
  const int R0 = b * SEG + c * 128;
  bf16* Xt = (bf16*)smem;
  bf16* Bt = Xt + 64 * 136;
  float* dts = (float*)(smem + 2 * 64 * 136 * 2);
  float* das = dts + 256;
  float* acs = das + 256;
  float* wgt = acs + 256;
  ssd_dt(p, l, R0, hh, dts, das, acs);
  ssd_load_tile(p, l, R0, hh * 64, Xt, 136, true);
  ssd_load_tile(p, l, R0, 384 + (hh / 3) * 64, Bt, 136, true);
  {
    int t = tidx() & 127, d = tidx() >> 7;
    float wv = d == 0 ? dts[t] * __expf(acs[127] - acs[t]) : dts[128 + t] * __expf(acs[128 + t] - das[128 + t]);
    wgt[d * 128 + t] = wv;
    if (tidx() < 2) {
      float* cd = (float*)(wsp(p) + OFF_SSDCD);
      cd[((b * 2 + tidx()) * 66 + c) * 6 + hh] = __expf(acs[tidx() * 128 + 127]);
    }
  }
  __syncthreads();
  const int lane = tidx() & 63, w = tidx() >> 6, r = lane & 31, h = lane >> 5;
  const int mt = w >> 1, nt = w & 1;
  float* S = (float*)(wsp(p) + OFF_SSDS);
  for (int d = 0; d < 2; ++d) {
    f32x16 acc = zero16();
#pragma unroll
    for (int ks = 0; ks < 8; ++ks) {
      bf16x8 a = *(const bf16x8*)(Xt + (32 * mt + r) * 136 + 16 * ks + 8 * h);
      bf16x8 bv = *(const bf16x8*)(Bt + (32 * nt + r) * 136 + 16 * ks + 8 * h);
#pragma unroll
      for (int e = 0; e < 8; ++e) a[e] = (bf16)((float)a[e] * wgt[d * 128 + 16 * ks + 8 * h + e]);
      acc = mfma32(a, bv, acc);
    }
    float* so = S + ((size_t)((b * 2 + d) * 66 + c) * 6 + hh) * 4096;
#pragma unroll
    for (int reg = 0; reg < 16; ++reg) {
      int pp = 32 * mt + (reg & 3) + 8 * (reg >> 2) + 4 * h;
      so[pp * 64 + 32 * nt + r] = acc[reg];
    }
  }
  __syncthreads();
}
__device__ NOPK void ssd_carry_item(const Params& p, int item) {
  int e = item * 256 + tidx();
  int pn = e & 4095, hh = (e >> 12) % 6, d = (e / (4096 * 6)) & 1, b = e / (4096 * 12);
  float* S = (float*)(wsp(p) + OFF_SSDS);
  const float* cd = (const float*)(wsp(p) + OFF_SSDCD);
  float s = 0.f;
  for (int o0 = 0; o0 < 66; o0 += 6) {
    float tmp[6], cdv[6]; size_t idx[6];
#pragma unroll
    for (int j = 0; j < 6; ++j) {
      int o = o0 + j;
      int c = d ? (o < 2 ? 1 - o : 67 - o) : o;
      idx[j] = ((size_t)((b * 2 + d) * 66 + c) * 6 + hh);
      tmp[j] = S[idx[j] * 4096 + pn];
      cdv[j] = cd[idx[j]];
    }
#pragma unroll
    for (int j = 0; j < 6; ++j) {
      S[idx[j] * 4096 + pn] = s;
      s = cdv[j] * s + tmp[j];
    }
  }
}
__device__ NOPK void ssdb_item(const Params& p, int l, int item, char* smem) {
  const int hh = item % 6, c = (item / 6) % 66, b = item / 396;
  const int R0 = b * SEG + c * 128;
  bf16* Xt = (bf16*)smem;
  bf16* Bs = Xt + 64 * 136;
  bf16* Cs = Bs + 128 * 72;
  float* dts = (float*)(smem + (64 * 136 + 2 * 128 * 72) * 2);
  float* das = dts + 256;
  float* acs = das + 256;
  ssd_dt(p, l, R0, hh, dts, das, acs);
  ssd_load_tile(p, l, R0, hh * 64, Xt, 136, true);
  ssd_load_tile(p, l, R0, 384 + (hh / 3) * 64, Bs, 72, false);
  ssd_load_tile(p, l, R0, 512 + (hh / 3) * 64, Cs, 72, false);
  __syncthreads();
  const int lane = tidx() & 63, w = tidx() >> 6, r = lane & 31, h = lane >> 5;
  bf16x8 cfrag[4];
#pragma unroll
  for (int ks = 0; ks < 4; ++ks) cfrag[ks] = *(const bf16x8*)(Cs + (32 * w + r) * 72 + 16 * ks + 8 * h);
  f32x16 yacc[2] = {zero16(), zero16()};
  const int lq = 32 * w + r;
  const float acf_l = acs[lq], aeb_l = acs[128 + lq] - das[128 + lq];
#pragma unroll 1
  for (int st = 0; st < 4; ++st) {
    f32x16 g = zero16();
#pragma unroll
    for (int ks = 0; ks < 4; ++ks) {
      bf16x8 a = *(const bf16x8*)(Bs + (32 * st + r) * 72 + 16 * ks + 8 * h);
      g = mfma32(a, cfrag[ks], g);
    }
    bf16x8 mf[2];
#pragma unroll
    for (int reg = 0; reg < 16; ++reg) {
      int s = 32 * st + (reg & 3) + 8 * (reg >> 2) + 4 * h;
      float m = 0.f;
      if (s <= lq) m += __expf(acf_l - acs[s]) * dts[s];
      if (s >= lq) m += __expf((acs[128 + s] - das[128 + s]) - aeb_l) * dts[128 + s];
      mf[reg >> 3][reg & 7] = (bf16)(g[reg] * m);
    }
#pragma unroll
    for (int k2 = 0; k2 < 2; ++k2)
#pragma unroll
      for (int pt = 0; pt < 2; ++pt) {
        const bf16* xs = Xt + (32 * pt + r) * 136 + 32 * st + 16 * k2 + 4 * h;
        bf16x4 lo = *(const bf16x4*)xs, hi = *(const bf16x4*)(xs + 8);
        bf16x8 bv;
#pragma unroll
        for (int e = 0; e < 4; ++e) { bv[e] = lo[e]; bv[4 + e] = hi[e]; }
        yacc[pt] = mfma32(mf[k2], bv, yacc[pt]);
      }
  }
  const float* S = (const float*)(wsp(p) + OFF_SSDS);
  for (int d = 0; d < 2; ++d) {
    const float* si = S + ((size_t)((b * 2 + d) * 66 + c) * 6 + hh) * 4096;
    f32x16 facc[2] = {zero16(), zero16()};
#pragma unroll
    for (int ks = 0; ks < 4; ++ks)
#pragma unroll
      for (int pt = 0; pt < 2; ++pt) {
        const float* sp = si + (32 * pt + r) * 64 + 16 * ks + 8 * h;
        float4 s0 = *(const float4*)sp, s1 = *(const float4*)(sp + 4);
        bf16x8 bv;
        bv[0] = (bf16)s0.x; bv[1] = (bf16)s0.y; bv[2] = (bf16)s0.z; bv[3] = (bf16)s0.w;
        bv[4] = (bf16)s1.x; bv[5] = (bf16)s1.y; bv[6] = (bf16)s1.z; bv[7] = (bf16)s1.w;
        facc[pt] = mfma32(cfrag[ks], bv, facc[pt]);
      }
#pragma unroll
    for (int reg = 0; reg < 16; ++reg) {
      int lr = 32 * w + (reg & 3) + 8 * (reg >> 2) + 4 * h;
      float sc = d == 0 ? __expf(acs[lr]) : __expf(acs[128 + 127] - (acs[128 + lr] - das[128 + lr]));
      yacc[0][reg] += sc * facc[0][reg];
      yacc[1][reg] += sc * facc[1][reg];
    }
  }
  const bf16* P = (const bf16*)(wsp(p) + OFF_P);
  bf16* yo = (bf16*)(wsp(p) + OFF_YB) + (size_t)2 * TROWS * 384;
  const float dsk = p.in[26][l * 6 + hh];
#pragma unroll
  for (int pt = 0; pt < 2; ++pt)
#pragma unroll
    for (int reg = 0; reg < 16; ++reg) {
      int lr = 32 * w + (reg & 3) + 8 * (reg >> 2) + 4 * h;
      int pp = 32 * pt + r;
      float x = (float)Xt[pp * 136 + lr];
      float y = yacc[pt][reg] + dsk * x;
      float z = (float)P[(size_t)(R0 + lr) * PLD + PC_Z + hh * 64 + pp];
      yo[(size_t)(R0 + lr) * 384 + hh * 64 + pp] = (bf16)(y * silu_f(z));
    }
  __syncthreads();
}

__device__ NOPK void mla_fin_item(const Params& p, int l, int item) {
  const int sub = tidx() >> 5, ln = tidx() & 31;
  const bf16* P = (const bf16*)(wsp(p) + OFF_P);
  float e0[4], e1[4], e2[4];
  bf16* base[4]; int jj[4]; bool isKv[4];
#pragma unroll
  for (int q = 0; q < 4; ++q) {
    const int u = item * 32 + q * 8 + sub;
    const bool isK = u >= TROWS * 6;
    const int uu = isK ? u - TROWS * 6 : u;
    const int row = uu / 6, head = uu % 6;
    jj[q] = row % SEG; isKv[q] = isK;
    base[q] = isK ? (bf16*)(wsp(p) + OFF_KF) + (size_t)row * KLD + head * 96 : (bf16*)(wsp(p) + OFF_Q) + (size_t)row * QLD + head * 96;
    e0[q] = (float)base[q][ln]; e1[q] = (float)base[q][32 + ln];
    e2[q] = isK ? (float)P[(size_t)row * PLD + PC_KR + ln] : (float)base[q][64 + ln];
  }
#pragma unroll
  for (int q = 0; q < 4; ++q) {
    float ss = e0[q] * e0[q] + e1[q] * e1[q] + e2[q] * e2[q];
    for (int o = 16; o > 0; o >>= 1) ss += __shfl_xor(ss, o);
    const float rinv = rsqrtf(ss * (1.f / 96.f) + 1e-6f);
    const float* gn = p.in[isKv[q] ? 33 : 32] + l * 96;
    float a0 = e0[q] * rinv * gn[ln], a1 = e1[q] * rinv * gn[32 + ln], a2 = e2[q] * rinv * gn[64 + ln];
    float other = __shfl_xor(a2, 16);
    if (jj[q] >= CTXL) {
      int pos = jj[q] - CTXL;
      int i = ln & 15;
      float pv = (i < 8) ? (float)(pos >> 6) : (float)(pos & 63);
      float inv = powf(10000.f, -(float)(i & 7) / 8.f);
      float ang = pv * inv;
      float cs = cosf(ang), sn = sinf(ang);
      a2 = (ln < 16) ? (a2 * cs - other * sn) : (other * sn + a2 * cs);
    }
    const float qs = isKv[q] ? 1.f : 0.10206207262f * 1.44269504089f;
    base[q][ln] = (bf16)(a0 * qs); base[q][32 + ln] = (bf16)(a1 * qs); base[q][64 + ln] = (bf16)(a2 * qs);
  }
}

__device__ NOPK void attn_item(const Params& p, int l, int item, char* smem) {
  int b, head, qb;
  if (item < 768) { qb = 2 + item % 64; head = (item / 64) % 6; b = item / 384; }
  else { int i2 = item - 768; qb = i2 % 2; head = (i2 / 2) % 6; b = i2 / 12; }
  const int nkeys = qb < 2 ? CTXL : SEG;
  const int tid = tidx(), lane = tid & 63, w = tid >> 6, r = lane & 31, h = lane >> 5;
  bf16* Ks = (bf16*)smem;
  bf16* Vs = Ks + 2 * 64 * 104;
  const bf16* Q = (const bf16*)(wsp(p) + OFF_Q);
  const bf16* KF = (const bf16*)(wsp(p) + OFF_KF);
  const bf16* VT = (const bf16*)(wsp(p) + OFF_VT) + (size_t)(b * 6 + head) * 64 * SEG;
  float mq = 0.f, mk = 0.f;
  for (int i = 0; i < 96; ++i) { mq = fmaxf(mq, fabsf(p.in[32][l * 96 + i])); mk = fmaxf(mk, fabsf(p.in[33][l * 96 + i])); }
  const float mb = 9.79795897f * 1.44269504089f * mq * mk * 1.0001f;
  bf16x8 qf[6];
  {
    const bf16* qp = Q + (size_t)(b * SEG + qb * 128 + 32 * w + r) * QLD + head * 96 + 8 * h;
#pragma unroll
    for (int ks = 0; ks < 6; ++ks) qf[ks] = *(const bf16x8*)(qp + 16 * ks);
  }
  f32x16 oacc[2] = {zero16(), zero16()};
  float lsum = 0.f;
  uint4 pk0, pk1, pk2, pv0, pv1;
  uint4 qk0, qk1, qk2, qv0, qv1;
  const bf16* kbase = KF + (size_t)(b * SEG) * KLD + head * 96;
  const int c0 = tid, c1 = tid + 256, c2 = tid + 512;
  const bf16* kg0 = kbase + (size_t)(c0 / 12) * KLD + (c0 % 12) * 8;
  const bf16* kg1 = kbase + (size_t)(c1 / 12) * KLD + (c1 % 12) * 8;
  const bf16* kg2 = kbase + (size_t)(c2 / 12) * KLD + (c2 % 12) * 8;
  const bf16* vg0 = VT + (size_t)(c0 >> 3) * SEG + (c0 & 7) * 8;
  const bf16* vg1 = VT + (size_t)(c1 >> 3) * SEG + (c1 & 7) * 8;
  const int ko0 = (c0 / 12) * 104 + (c0 % 12) * 8, ko1 = (c1 / 12) * 104 + (c1 % 12) * 8, ko2 = (c2 / 12) * 104 + (c2 % 12) * 8;
  const int vo0 = (c0 >> 3) * 72 + (c0 & 7) * 8, vo1 = (c1 >> 3) * 72 + (c1 & 7) * 8;
  const int nt = nkeys / 64;
#define AGLOAD(S, t) { const size_t kof = (size_t)(t) * 64 * KLD; const int vof = (t) * 64; \
  S##k0 = ldg16(kg0 + kof); S##k1 = ldg16(kg1 + kof); S##k2 = ldg16(kg2 + kof); S##v0 = ldg16(vg0 + vof); S##v1 = ldg16(vg1 + vof); }
#define ASTORE(S, buf) { \
  *(uint4*)(Ks + (buf) * 64 * 104 + ko0) = S##k0; *(uint4*)(Ks + (buf) * 64 * 104 + ko1) = S##k1; *(uint4*)(Ks + (buf) * 64 * 104 + ko2) = S##k2; \
  *(uint4*)(Vs + (buf) * 64 * 72 + vo0) = S##v0; *(uint4*)(Vs + (buf) * 64 * 72 + vo1) = S##v1; }
#define ACOMPUTE(buf) { \
    const bf16* ks_ = Ks + (buf) * 64 * 104; \
    const bf16* vs_ = Vs + (buf) * 64 * 72; \
    _Pragma("unroll") for (int sub = 0; sub < 2; ++sub) { \
      f32x16 s = zero16(); \
      _Pragma("unroll") for (int ks = 0; ks < 6; ++ks) { \
        bf16x8 a = *(const bf16x8*)(ks_ + (32 * sub + r) * 104 + 16 * ks + 8 * h); \
        s = mfma32(a, qf[ks], s); } \
      bf16x8 pf[2]; \
      _Pragma("unroll") for (int reg = 0; reg < 16; ++reg) { \
        float e = __builtin_amdgcn_exp2f(s[reg] - mb); lsum += e; pf[reg >> 3][reg & 7] = (bf16)e; } \
      _Pragma("unroll") for (int k2 = 0; k2 < 2; ++k2) \
        _Pragma("unroll") for (int dt = 0; dt < 2; ++dt) { \
          const bf16* vp = vs_ + (32 * dt + r) * 72 + 32 * sub + 16 * k2 + 4 * h; \
          bf16x4 lo = *(const bf16x4*)vp, hi = *(const bf16x4*)(vp + 8); \
          bf16x8 va; \
          _Pragma("unroll") for (int e = 0; e < 4; ++e) { va[e] = lo[e]; va[4 + e] = hi[e]; } \
          oacc[dt] = mfma32(va, pf[k2], oacc[dt]); } } }
  AGLOAD(p, 0)
  AGLOAD(q, 1)
  for (int kt = 0; kt < nt; kt += 2) {
    ASTORE(p, 0)
    __syncthreads();
    if (kt + 2 < nt) AGLOAD(p, kt + 2)
    ACOMPUTE(0)
    ASTORE(q, 1)
    __syncthreads();
    if (kt + 3 < nt) AGLOAD(q, kt + 3)
    ACOMPUTE(1)
  }
#undef AGLOAD
#undef ASTORE
#undef ACOMPUTE
  __syncthreads();
  lsum += __shfl_xor(lsum, 32);
  const float linv = 1.f / lsum;
  bf16* yo = (bf16*)(wsp(p) + OFF_YB) + (size_t)3 * TROWS * 384;
  const size_t orow = (size_t)(b * SEG + qb * 128 + 32 * w + r) * 384 + head * 64;
#pragma unroll
  for (int dt = 0; dt < 2; ++dt)
#pragma unroll
    for (int g4 = 0; g4 < 4; ++g4) {
      int dv = 32 * dt + 8 * g4 + 4 * h;
      uint2 u;
      u.x = pack2(oacc[dt][4 * g4] * linv, oacc[dt][4 * g4 + 1] * linv);
      u.y = pack2(oacc[dt][4 * g4 + 2] * linv, oacc[dt][4 * g4 + 3] * linv);
      *(uint2*)(yo + orow + dv) = u;
    }
}

__device__ NOPK void pgemm_item(const Params& p, int it, char* smem) {
  char* ws = wsp(p);
  int mt = it / 23, nt = it % 23;
  f32x16 acc[4][2];
#pragma unroll
  for (int i = 0; i < 4; ++i) { acc[i][0] = zero16(); acc[i][1] = zero16(); }
  gemm_core_big(acc, (const bf16*)(ws + OFF_H) + (size_t)mt * 256 * DM, DM, (const bf16*)(ws + OFF_WIN) + (size_t)nt * 128 * DM, DM, DM, smem);
  bf16* P = (bf16*)(ws + OFF_P) + (size_t)mt * 256 * PLD + nt * 128;
  const int lane = tidx() & 63, w = tidx() >> 6, wm = w >> 1, wn = w & 1, r = lane & 31, h = lane >> 5;
#pragma unroll
  for (int mi = 0; mi < 4; ++mi)
#pragma unroll
    for (int ni = 0; ni < 2; ++ni)
#pragma unroll
      for (int reg = 0; reg < 16; ++reg) {
        int row = wm * 128 + mi * 32 + (reg & 3) + 8 * (reg >> 2) + 4 * h;
        gst(P + (size_t)row * PLD + wn * 64 + ni * 32 + r, (bf16)acc[mi][ni][reg]);
      }
}
__device__ NOPK void mlaq_item(const Params& p, int it, char* smem) {
  char* ws = wsp(p);
  float* rs = (float*)(smem + 73728);
  int mt = it / 5, nt = it % 5;
  const bf16* A = (const bf16*)(ws + OFF_P) + (size_t)mt * 128 * PLD + PC_CQ;
  row_rms(A, PLD, 384, 1e-6f, rs);
  f32x16 acc[2][2]; zero_acc(acc);
  gemm_core(acc, A, PLD, (const bf16*)(ws + OFF_WUQ) + (size_t)nt * 128 * 384, 384, 384, smem);
  bf16* Q = (bf16*)(ws + OFF_Q) + (size_t)mt * 128 * QLD + nt * 128;
  gemm_epi(acc, [&](int row, int col, float v) NOPK { gst(Q + (size_t)row * QLD + col, (bf16)(v * rs[row])); });
  __syncthreads();
}
__device__ NOPK void mlakv_item(const Params& p, int it, char* smem) {
  char* ws = wsp(p);
  float* rs = (float*)(smem + 73728);
  int mt = it / 6, nt = it % 6;
  const bf16* A = (const bf16*)(ws + OFF_P) + (size_t)mt * 128 * PLD + PC_CKV;
  row_rms(A, PLD, 256, 1e-6f, rs);
  f32x16 acc[2][2]; zero_acc(acc);
  gemm_core(acc, A, PLD, (const bf16*)(ws + OFF_WUKV) + (size_t)nt * 128 * 256, 256, 256, smem);
  const int R0 = mt * 128, b = R0 / SEG, j0 = R0 % SEG;
  bf16* KFp = (bf16*)(ws + OFF_KF) + (size_t)R0 * KLD + nt * 96;
  bf16* VTp = (bf16*)(ws + OFF_VT) + (size_t)(b * 6 + nt) * 64 * SEG + j0;
  {
    const int lane = tidx() & 63, w = tidx() >> 6, wm = w >> 1, wn = w & 1, r = lane & 31, h = lane >> 5;
#pragma unroll
    for (int mi = 0; mi < 2; ++mi)
#pragma unroll
      for (int ni = 0; ni < 2; ++ni)
#pragma unroll
        for (int g4 = 0; g4 < 4; ++g4) {
          const int row0 = wm * 64 + mi * 32 + 8 * g4 + 4 * h, col = wn * 64 + ni * 32 + r;
          float o0 = acc[mi][ni][4 * g4] * rs[row0], o1 = acc[mi][ni][4 * g4 + 1] * rs[row0 + 1];
          float o2 = acc[mi][ni][4 * g4 + 2] * rs[row0 + 2], o3 = acc[mi][ni][4 * g4 + 3] * rs[row0 + 3];
          if (wn == 0) {
            KFp[(size_t)row0 * KLD + col] = (bf16)o0; KFp[(size_t)(row0 + 1) * KLD + col] = (bf16)o1;
            KFp[(size_t)(row0 + 2) * KLD + col] = (bf16)o2; KFp[(size_t)(row0 + 3) * KLD + col] = (bf16)o3;
          } else {
            uint2 u; u.x = pack2(o0, o1); u.y = pack2(o2, o3);
            *(uint2*)(VTp + (size_t)(col - 64) * SEG + row0) = u;
          }
        }
  }
  __syncthreads();
}
__device__ NOPK void glu_item(const Params& p, int it, char* smem) {
  char* ws = wsp(p);
  int mt = it / 3, nt = it % 3;
  f32x16 acc[2][2]; zero_acc(acc);
  const bf16* A = (const bf16*)(ws + OFF_YS5) + (size_t)mt * 128 * 384;
  gemm_core(acc, A, 384, (const bf16*)(ws + OFF_WGLU) + (size_t)nt * 128 * 384, 384, 384, smem);
  bf16* yo = (bf16*)(ws + OFF_YB) + (size_t)mt * 128 * 384 + nt * 128;
  const bf16* yi = A + nt * 128;
  gemm_epi(acc, [&](int row, int col, float v) NOPK {
    float a = (float)gld(yi + (size_t)row * 384 + col);
    gst(yo + (size_t)row * 384 + col, (bf16)(a * sigm(v)));
  });
}
__device__ NOPK void merge_item(const Params& p, int it, char* smem) {
  char* ws = wsp(p);
  const int tid = tidx();
  int mt = it / 16, nt = it % 16;
  float* rs = (float*)(smem + 73728);
  const bf16* Ah = (const bf16*)(ws + OFF_H) + (size_t)mt * 128 * DM;
  const bf16* Wg = (const bf16*)(ws + OFF_WG) + (size_t)(nt * 64) * DM;
  const bf16* Yb = (const bf16*)(ws + OFF_YB) + (size_t)(mt * 128) * 384;
  const bf16* Wb = (const bf16*)(ws + OFF_WBR) + (size_t)(nt * 64) * 384;
  Stage6 P, Q;
  {
    const int srow = tid >> 3, spart = tid & 7;
    chain_load(P, Ah + (size_t)srow * DM + spart * 8, DM, Wg + (size_t)srow * DM + spart * 8, DM, 0);
    chain_load(Q, Ah + (size_t)srow * DM + spart * 8, DM, Wg + (size_t)srow * DM + spart * 8, DM, BKK);
  }
  row_rms((const bf16*)(ws + OFF_YB) + ((size_t)2 * TROWS + mt * 128) * 384, 384, 384, 1e-6f, rs);
  const int lane = tid & 63, w = tid >> 6, wm = w >> 1, wn = w & 1, r = lane & 31, h = lane >> 5;
  f32x16 macc[2][1]; macc[0][0] = zero16(); macc[1][0] = zero16();
#pragma unroll 1
  for (int br = 0; br < 4; ++br) {
    const bf16* Ab = Yb + (size_t)br * TROWS * 384;
    const bf16* Bb = Wb + (size_t)br * 1024 * 384;
    unsigned gs[2][8];
    {
      f32x16 gacc[2][1]; gacc[0][0] = zero16(); gacc[1][0] = zero16();
      gemm_chain(gacc, P, Q, Ah, DM, Wg + (size_t)br * 1024 * DM, DM, DM, Ab, 384, Bb, 384, smem);
#pragma unroll
      for (int mi = 0; mi < 2; ++mi)
#pragma unroll
        for (int q = 0; q < 8; ++q) gs[mi][q] = pack2(sigm(gacc[mi][0][2 * q]), sigm(gacc[mi][0][2 * q + 1]));
    }
    f32x16 bacc[2][1]; bacc[0][0] = zero16(); bacc[1][0] = zero16();
    gemm_chain(bacc, P, Q, Ab, 384, Bb, 384, 384, br < 3 ? Ah : (const bf16*)nullptr, DM, Wg + (size_t)(br < 3 ? br + 1 : 0) * 1024 * DM, DM, smem);
#pragma unroll
    for (int mi = 0; mi < 2; ++mi)
#pragma unroll
      for (int reg = 0; reg < 16; ++reg) {
        unsigned u = gs[mi][reg >> 1];
        float gate = __uint_as_float((reg & 1) ? (u & 0xffff0000u) : (u << 16));
        int row = wm * 64 + mi * 32 + (reg & 3) + 8 * (reg >> 2) + 4 * h;
        float sc = br == 2 ? rs[row] : 1.f;
        macc[mi][0][reg] += gate * sc * bacc[mi][0][reg];
      }
  }
  bf16* MG = (bf16*)(ws + OFF_MG) + (size_t)mt * 128 * DM + nt * 64;
#pragma unroll
  for (int mi = 0; mi < 2; ++mi)
#pragma unroll
    for (int reg = 0; reg < 16; ++reg) {
      int row = wm * 64 + mi * 32 + (reg & 3) + 8 * (reg >> 2) + 4 * h;
      gst(MG + (size_t)row * DM + wn * 32 + r, (bf16)macc[mi][0][reg]);
    }
  __syncthreads();
}
__device__ __forceinline__ NOPK void n1024_tile(int it, int& mt, int& n0, bool& half) {
  if (it < 992) { mt = it >> 3; n0 = (it & 7) * 128; half = false; }
  else { int hh = it - 992; int tile = 992 + (hh >> 1); mt = tile >> 3; n0 = (tile & 7) * 128 + (hh & 1) * 64; half = true; }
}
__device__ NOPK void wout_item(const Params& p, int l, int it, char* smem) {
  char* ws = wsp(p);
  int mt, n0; bool half;
  n1024_tile(it, mt, n0, half);
  const int R0 = mt * 128, b = R0 / SEG, j0 = R0 % SEG, v = j0 < CTXL ? 2 : b;
  const float* g1 = (const float*)(ws + OFF_MOD) + (size_t)(l * 3 + v) * 6144 + 2048 + n0;
  float* X = (float*)(ws + OFF_X) + (size_t)R0 * DM + n0;
  const bf16* A = (const bf16*)(ws + OFF_MG) + (size_t)mt * 128 * DM;
  const bf16* B = (const bf16*)(ws + OFF_WOUT) + (size_t)n0 * DM;
  const int lane = tidx() & 63, w = tidx() >> 6, wm = w >> 1, wn = w & 1, r = lane & 31, h = lane >> 5;
  if (!half) {
    f32x16 acc[2][2]; zero_acc(acc);
    gemm_core(acc, A, DM, B, DM, DM, smem);
    gemm_epi(acc, [&](int row, int col, float val) NOPK { float* xp = X + (size_t)row * DM + col; gst(xp, gld(xp) + gld(g1 + col) * val); });
  } else {
    f32x16 acc[2][1]; acc[0][0] = zero16(); acc[1][0] = zero16();
    gemm_core_t<1>(acc, A, DM, B, DM, DM, smem);
#pragma unroll
    for (int mi = 0; mi < 2; ++mi)
#pragma unroll
      for (int reg = 0; reg < 16; ++reg) {
        int row = wm * 64 + mi * 32 + (reg & 3) + 8 * (reg >> 2) + 4 * h, col = wn * 32 + r;
        { float* xp = X + (size_t)row * DM + col; gst(xp, gld(xp) + gld(g1 + col) * acc[mi][0][reg]); }
      }
  }
}
__device__ NOPK void ffi_item(const Params& p, int it, char* smem) {
  char* ws = wsp(p);
  int mt = it / 44, nt = it % 44;
  f32x16 acc[4][2];
#pragma unroll
  for (int i = 0; i < 4; ++i) { acc[i][0] = zero16(); acc[i][1] = zero16(); }
  gemm_core_big(acc, (const bf16*)(ws + OFF_H) + (size_t)mt * 256 * DM, DM, (const bf16*)(ws + OFF_WFI) + (size_t)nt * 128 * DM, DM, DM, smem);
  bf16* HID = (bf16*)(ws + OFF_HID) + (size_t)mt * 256 * FFH + nt * 64;
  const int lane = tidx() & 63, w = tidx() >> 6, wm = w >> 1, wn = w & 1, r = lane & 31, h = lane >> 5;
#pragma unroll
  for (int mi = 0; mi < 4; ++mi)
#pragma unroll
    for (int reg = 0; reg < 16; ++reg) {
      int row = wm * 128 + mi * 32 + (reg & 3) + 8 * (reg >> 2) + 4 * h;
      float gv = acc[mi][0][reg], uv = acc[mi][1][reg];
      gst(HID + (size_t)row * FFH + wn * 32 + r, (bf16)(silu_f(gv) * uv));
    }
}
__device__ NOPK void ffo_item(const Params& p, int l, int it, char* smem) {
  char* ws = wsp(p);
  int mt, n0; bool half;
  n1024_tile(it, mt, n0, half);
  const int R0 = mt * 128, b = R0 / SEG, j0 = R0 % SEG, v = j0 < CTXL ? 2 : b;
  const float* g2 = (const float*)(ws + OFF_MOD) + (size_t)(l * 3 + v) * 6144 + 5120 + n0;
  float* X = (float*)(ws + OFF_X) + (size_t)R0 * DM + n0;
  float* O = p.out + ((size_t)b * 8192 + (j0 - CTXL)) * DM + n0;
  const bool wr = (l == 3) && (j0 >= CTXL);
  const bf16* A = (const bf16*)(ws + OFF_HID) + (size_t)mt * 128 * FFH;
  const bf16* B = (const bf16*)(ws + OFF_WFO) + (size_t)n0 * FFH;
  const int lane = tidx() & 63, w = tidx() >> 6, wm = w >> 1, wn = w & 1, r = lane & 31, h = lane >> 5;
  if (!half) {
    f32x16 acc[2][2]; zero_acc(acc);
    gemm_core(acc, A, FFH, B, FFH, FFH, smem);
    gemm_epi(acc, [&](int row, int col, float val) NOPK {
      float* xp = X + (size_t)row * DM + col;
      float xn = gld(xp) + gld(g2 + col) * val;
      gst(xp, xn);
      if (wr) gst(O + (size_t)row * DM + col, xn);
    });
  } else {
    f32x16 acc[2][1]; acc[0][0] = zero16(); acc[1][0] = zero16();
    gemm_core_t<1>(acc, A, FFH, B, FFH, FFH, smem);
#pragma unroll
    for (int mi = 0; mi < 2; ++mi)
#pragma unroll
      for (int reg = 0; reg < 16; ++reg) {
        int row = wm * 64 + mi * 32 + (reg & 3) + 8 * (reg >> 2) + 4 * h, col = wn * 32 + r;
        float* xp = X + (size_t)row * DM + col;
        float xn = gld(xp) + gld(g2 + col) * acc[mi][0][reg];
        gst(xp, xn);
        if (wr) gst(O + (size_t)row * DM + col, xn);
      }
  }
}
__device__ NOPK void p0a_item(const Params& p, int it) {
  char* ws = wsp(p);
  const int tid = tidx();
  if (it < 1536) {
    int kc = it % 16, nc = (it / 16) % 24, l = it / 384;
    int n = nc * 256 + tid;
    const float* wa = p.in[4] + (size_t)l * 1024 * 6144 + n;
    float a0 = 0.f, a1 = 0.f, a2 = 0.f;
    for (int k = kc * 64; k < kc * 64 + 64; ++k) {
      float wv = wa[(size_t)k * 6144];
      a0 += silu_f(p.in[1][k]) * wv; a1 += silu_f(p.in[1][1024 + k]) * wv; a2 += silu_f(p.in[3][k]) * wv;
    }
    float* mp = (float*)(ws + OFF_MODP) + (size_t)(l * 16 + kc) * 3 * 6144;
    mp[n] = a0; mp[6144 + n] = a1; mp[2 * 6144 + n] = a2;
  } else {
    int i2 = it - 1536;
    for (int rr = 0; rr < 4; ++rr) {
      int row = i2 * 4 + rr;
      int b = row / SEG, j = row % SEG;
      const float* src = j < CTXL ? p.in[2] + ((size_t)b * CTXL + j) * DM : p.in[0] + ((size_t)b * 8192 + (j - CTXL)) * DM;
      ((float4*)(ws + OFF_X))[(size_t)row * 256 + tid] = ((const float4*)src)[tid];
    }
  }
}
__device__ NOPK void p0b_item(const Params& p, int it) {
  char* ws = wsp(p);
  int e = it * 256 + tidx();
  int n = e % 6144, v = (e / 6144) % 3, l = e / (3 * 6144);
  float s = p.in[5][l * 6144 + n];
  const float* mp = (const float*)(ws + OFF_MODP) + (size_t)l * 16 * 3 * 6144 + v * 6144 + n;
  for (int kc = 0; kc < 16; ++kc) s += mp[(size_t)kc * 3 * 6144];
  ((float*)(ws + OFF_MOD))[e] = s;
}

__device__ __forceinline__ NOPK void grid_barrier(unsigned* ctl, unsigned k, int nb, int bid) {
  asm volatile("s_waitcnt vmcnt(0)" ::: "memory");
  __syncthreads();
  if (__builtin_amdgcn_workitem_id_x() == 0) {
    __builtin_amdgcn_fence(__ATOMIC_RELEASE, "agent");
    asm volatile("s_waitcnt vmcnt(0)" ::: "memory");
    const int leaf = bid & 63;
    unsigned old = __hip_atomic_fetch_add(ctl + 256 + leaf * 8, 1u, __ATOMIC_RELAXED, __HIP_MEMORY_SCOPE_AGENT);
    if (old + 1 == k * (unsigned)(nb >> 6)) {
      unsigned o1 = __hip_atomic_fetch_add(ctl + 176 + (leaf & 7) * 8, 1u, __ATOMIC_RELAXED, __HIP_MEMORY_SCOPE_AGENT);
      if (o1 + 1 == k * 8u) {
        unsigned o2 = __hip_atomic_fetch_add(ctl, 1u, __ATOMIC_RELAXED, __HIP_MEMORY_SCOPE_AGENT);
        if (o2 + 1 == k * 8u) __hip_atomic_store(ctl + 16, k, __ATOMIC_RELAXED, __HIP_MEMORY_SCOPE_AGENT);
      }
    }
    while (__hip_atomic_load(ctl + 16, __ATOMIC_RELAXED, __HIP_MEMORY_SCOPE_AGENT) < k) __builtin_amdgcn_s_sleep(4);
    __builtin_amdgcn_fence(__ATOMIC_ACQUIRE, "agent");
    asm volatile("s_waitcnt vmcnt(0)" ::: "memory");
  }
  __syncthreads();
}
__device__ __forceinline__ NOPK int next_item(unsigned* head, char* smem, int nb) {
  int* sh = (int*)(smem + LDS_BYTES - 16);
  __syncthreads();
  if (__builtin_amdgcn_workitem_id_x() == 0) *sh = nb + (int)__hip_atomic_fetch_add(head, 1u, __ATOMIC_RELAXED, __HIP_MEMORY_SCOPE_AGENT);
  __syncthreads();
  return *sh;
}

__global__ NOPK void __launch_bounds__(256, 2) mega(Params p) {
  cg::grid_group grid = cg::this_grid();
  extern __shared__ __attribute__((aligned(16))) unsigned char lds[];
  char* smem = (char*)lds;
  const int nb = p.nblk, bid = __builtin_amdgcn_workgroup_id_x();
  const int lo = p.ph_lo, hi = p.ph_hi;
  unsigned* ctl = (unsigned*)(p.ws + OFF_CTL);
  unsigned nbar = 0;
  if (lo > 4096) grid.sync();
#define PHASE_BEGIN(n) if ((n) >= lo && (n) < hi) {
#define PHASE_END(n) if ((n) + 1 < hi) { \
    ++nbar; grid_barrier(ctl, nbar, nb, bid); } }
#ifdef DBG_PH
  if (lo == 100) {
#ifdef DBG_F32_OFF
    const float* Fq = (const float*)(p.ws + DBG_F32_OFF);
    for (size_t i = (size_t)bid * 256 + __builtin_amdgcn_workitem_id_x(); i < (size_t)2 * 8192 * 1024; i += (size_t)nb * 256)
      { float q = DBG_K * Fq[i % (size_t)DBG_N]; p.out[i] = q - floorf(q); }
#elif defined(DBG_BF16_OFF)
    const bf16* Bq = (const bf16*)(p.ws + DBG_BF16_OFF);
    for (size_t i = (size_t)bid * 256 + __builtin_amdgcn_workitem_id_x(); i < (size_t)2 * 8192 * 1024; i += (size_t)nb * 256)
      { float q = DBG_K * (float)Bq[i % (size_t)DBG_N]; p.out[i] = q - floorf(q); }
#else
    const float* X = (const float*)(p.ws + OFF_X);
    for (size_t i = (size_t)bid * 256 + __builtin_amdgcn_workitem_id_x(); i < (size_t)2 * 8192 * 1024; i += (size_t)nb * 256) {
      size_t row = i / 1024, c = i % 1024; size_t b = row / 8192, j = row % 8192;
      size_t xr = row < 512 ? (row / 256) * SEG + (row % 256) : b * SEG + CTXL + j;
      { float q = DBG_K * X[xr * 1024 + c]; p.out[i] = q - floorf(q); }
    }
#endif
    return;
  }
#endif

  PHASE_BEGIN(0)
  for (int it = bid; it < 1536 + 4224; it += nb) p0a_item(p, it);
  PHASE_END(0)
  PHASE_BEGIN(1)
  for (int it = bid; it < 288; it += nb) p0b_item(p, it);
  PHASE_END(1)

  for (int l = 0; l < 4; ++l) {
    const int pb = 2 + 10 * l;
    PHASE_BEGIN(pb + 0)
    for (int it = bid; it < WPREP_ITEMS + 4224; it += nb) {
      if (it < WPREP_ITEMS) wprep_item(p, l, it, smem);
      else norm_item(p, l, 0, it - WPREP_ITEMS);
    }
    PHASE_END(pb + 0)
    for (int rep = 0; rep < ((REPEAT_MASK >> 1) & 1) + 1; ++rep) {
    PHASE_BEGIN(pb + 1)
    for (int it = bid; it < 66 * 23; it += nb) pgemm_item(p, it, smem);
    PHASE_END(pb + 1)
    }
    for (int rep = 0; rep < ((REPEAT_MASK >> 2) & 1) + 1; ++rep) {
    PHASE_BEGIN(pb + 2)
    {
      constexpr int N_Q = 132 * 5, N_KV = 132 * 6, N_SGU = 792, N_S5A = 2 * 132 * 2 * 6, N_SSDA = 792;
      for (int it0 = bid; it0 < N_Q + N_KV + N_SGU + N_S5A + N_SSDA; it0 = next_item(ctl + 64 + pb + 2 + 48 * rep, smem, nb)) {
        int it = it0;
        if (it < N_Q) { mlaq_item(p, it, smem); continue; }
        it -= N_Q;
        if (it < N_KV) { mlakv_item(p, it, smem); continue; }
        it -= N_KV;
        if (it < N_SGU) { sgu_item(p, l, it, smem); continue; }
        it -= N_SGU;
        if (it < N_S5A) { s5a_item(p, it, smem); continue; }
        it -= N_S5A;
        ssda_item(p, l, it, smem);
      }
    }
    PHASE_END(pb + 2)
    }
    PHASE_BEGIN(pb + 3)
    {
      constexpr int N_S5B = 2 * 132 * 6, N_CAR = 384, N_FIN = 2 * TROWS * 6 / 32;
      for (int it0 = bid; it0 < N_S5B + N_CAR + N_FIN; it0 += nb) {
        int it = it0;
        if (it < N_S5B) { s5b_item(p, l, it, smem); continue; }
        it -= N_S5B;
        if (it < N_CAR) { ssd_carry_item(p, it); continue; }
        it -= N_CAR;
        mla_fin_item(p, l, it);
      }
    }
    PHASE_END(pb + 3)
    for (int rep = 0; rep < ((REPEAT_MASK >> 4) & 1) + 1; ++rep) {
    PHASE_BEGIN(pb + 4)
    {
      constexpr int N_ATT = 792, N_SSDB = 792, N_GLU = 132 * 3;
      for (int it = bid; it < N_ATT + N_SSDB + N_GLU; it = next_item(ctl + 64 + pb + 4 + 48 * rep, smem, nb)) {
        if (it < N_ATT) { attn_item(p, l, it, smem); continue; }
        it -= N_ATT;
        if (it < N_SSDB) { ssdb_item(p, l, it, smem); continue; }
        it -= N_SSDB;
        glu_item(p, it, smem);
      }
    }
    PHASE_END(pb + 4)
    }
    for (int rep = 0; rep < ((REPEAT_MASK >> 5) & 1) + 1; ++rep) {
    PHASE_BEGIN(pb + 5)
    for (int it = bid; it < 132 * 16; it = next_item(ctl + 64 + pb + 5 + 48 * rep, smem, nb)) merge_item(p, it, smem);
    PHASE_END(pb + 5)
    }
    PHASE_BEGIN(pb + 6)
    for (int it = bid; it < 1120; it = next_item(ctl + 64 + pb + 6, smem, nb)) wout_item(p, l, it, smem);
    PHASE_END(pb + 6)
    PHASE_BEGIN(pb + 7)
    for (int it = bid; it < 4224; it += nb) norm_item(p, l, 1, it);
    PHASE_END(pb + 7)
    for (int rep = 0; rep < ((REPEAT_MASK >> 8) & 1) + 1; ++rep) {
    PHASE_BEGIN(pb + 8)
    for (int it = bid; it < 66 * 44; it += nb) ffi_item(p, it, smem);
    PHASE_END(pb + 8)
    }
    PHASE_BEGIN(pb + 9)
    for (int it = bid; it < 1120; it = next_item(ctl + 64 + pb + 9, smem, nb)) ffo_item(p, l, it, smem);
    PHASE_END(pb + 9)
  }
}

#ifndef N_LAUNCH_SPLIT
#define N_LAUNCH_SPLIT 0
#endif
extern "C" void kernel_launch(void* const* d_in, const int* in_sizes, int n_in, void* d_out, int out_size, void* d_ws,
                              size_t ws_size, hipStream_t stream) {
  static int grid_blocks = 0;
  if (!grid_blocks) {
    int dev = 0, cus = 0, per_cu = 0;
    (void)hipGetDevice(&dev);
    (void)hipDeviceGetAttribute(&cus, hipDeviceAttributeMultiprocessorCount, dev);
    (void)hipFuncSetAttribute((const void*)mega, hipFuncAttributeMaxDynamicSharedMemorySize, LDS_BYTES);
    (void)hipOccupancyMaxActiveBlocksPerMultiprocessor(&per_cu, mega, 256, LDS_BYTES);
    if (per_cu < 1) per_cu = 1;
    if (per_cu > 2) per_cu = 2;
    grid_blocks = cus * per_cu;
    if (ws_size < WS_TOTAL) fprintf(stderr, "kernel_launch: workspace too small: need %zu have %zu\n", (size_t)WS_TOTAL, ws_size);
  }
  Params p{};
  for (int i = 0; i < 38; ++i) p.in[i] = (const float*)d_in[i];
  p.out = (float*)d_out;
  p.ws = (char*)d_ws;
  p.nblk = grid_blocks; p.pad0 = 0;
  (void)hipMemsetAsync((char*)d_ws + OFF_CTL, 0, 4096, stream);
#if N_LAUNCH_SPLIT
#ifdef DBG_PH
  for (int ph = 0; ph <= DBG_PH; ++ph) {
    p.ph_lo = ph; p.ph_hi = ph + 1;
    hipLaunchKernelGGL(mega, dim3(grid_blocks), dim3(256), LDS_BYTES, stream, p);
  }
  p.ph_lo = 100; p.ph_hi = 101;
  hipLaunchKernelGGL(mega, dim3(grid_blocks), dim3(256), LDS_BYTES, stream, p);
#else
  for (int ph = 0; ph < 42; ++ph) {
    p.ph_lo = ph; p.ph_hi = ph + 1;
    hipLaunchKernelGGL(mega, dim3(grid_blocks), dim3(256), LDS_BYTES, stream, p);
  }
#endif
#else
  p.ph_lo = 0; p.ph_hi = 42;
  void* args[] = {&p};
  hipError_t e = hipLaunchCooperativeKernel((void*)mega, dim3(grid_blocks), dim3(256), args, LDS_BYTES, stream);
  if (e != hipSuccess) fprintf(stderr, "cooperative launch failed: %s (grid %d)\n", hipGetErrorString(e), grid_blocks);
#endif
}
#if defined(__HIP_DEVICE_COMPILE__)
#pragma clang attribute pop
#endif
```

```cpp
#if defined(__HIP_DEVICE_COMPILE__)
#pragma clang attribute push(__attribute__((target("no-packed-fp32-ops"))), apply_to = function)
#endif
#include <hip/hip_runtime.h>
#include <hip/hip_cooperative_groups.h>
#include <cstdio>
#include <cstdint>
namespace cg = cooperative_groups;

#define NOPK
typedef __bf16 bf16;
using bf16x8 = __attribute__((ext_vector_type(8))) __bf16;
using bf16x4 = __attribute__((ext_vector_type(4))) __bf16;
using f32x16 = __attribute__((ext_vector_type(16))) float;

#define TROWS 16896
#define SEG 8448
#define CTXL 256
#define DM 1024
#define PLD 2944
#define PC_S5 0
#define PC_SGU 384
#define PC_Z 1152
#define PC_XBC 1536
#define PC_DT 2176
#define PC_CQ 2192
#define PC_CKV 2576
#define PC_KR 2832
#define QLD 640
#define KLD 576
#define FFH 2816

#define AL(x) (((x) + 255) & ~(size_t)255)
constexpr size_t OFF_X = 0;
constexpr size_t OFF_H = OFF_X + AL((size_t)TROWS * DM * 4);
constexpr size_t OFF_MG = OFF_H + AL((size_t)TROWS * DM * 2);
constexpr size_t OFF_P = OFF_MG + AL((size_t)TROWS * DM * 2);
constexpr size_t OFF_YB = OFF_P + AL((size_t)TROWS * PLD * 2);
constexpr size_t OFF_Q = OFF_YB + AL((size_t)4 * TROWS * 384 * 2);
constexpr size_t OFF_KF = OFF_Q + AL((size_t)TROWS * QLD * 2);
constexpr size_t OFF_VT = OFF_KF + AL((size_t)TROWS * KLD * 2);
constexpr size_t OFF_YS5 = OFF_VT + AL((size_t)2 * 6 * 64 * SEG * 2);
constexpr size_t OFF_MODP = OFF_YS5 + AL((size_t)TROWS * 384 * 2);
constexpr size_t OFF_MOD = OFF_MODP + AL((size_t)4 * 16 * 3 * 6144 * 4);
constexpr size_t OFF_S5LOC = OFF_MOD + AL((size_t)4 * 3 * 6144 * 4);
constexpr size_t OFF_SSDS = OFF_S5LOC + AL((size_t)2 * 2 * 132 * 24 * 128 * 4);
constexpr size_t OFF_SSDCD = OFF_SSDS + AL((size_t)2 * 2 * 66 * 6 * 4096 * 4);
constexpr size_t OFF_S5BB = OFF_SSDCD + AL((size_t)2 * 2 * 66 * 6 * 4);
constexpr size_t OFF_S5CM = OFF_S5BB + AL((size_t)2 * 24 * 128 * 16 * 2);
constexpr size_t OFF_S5AB = OFF_S5CM + AL((size_t)2 * 24 * 16 * 128 * 2);
constexpr size_t OFF_WIN = OFF_S5AB + AL((size_t)2 * 24 * 64 * 4 * 4);
constexpr size_t OFF_WG = OFF_WIN + AL((size_t)2944 * 1024 * 2);
constexpr size_t OFF_WUQ = OFF_WG + AL((size_t)4096 * 1024 * 2);
constexpr size_t OFF_WUKV = OFF_WUQ + AL((size_t)640 * 384 * 2);
constexpr size_t OFF_WGLU = OFF_WUKV + AL((size_t)768 * 256 * 2);
constexpr size_t OFF_WBR = OFF_WGLU + AL((size_t)384 * 384 * 2);
constexpr size_t OFF_WOUT = OFF_WBR + AL((size_t)4 * 1024 * 384 * 2);
constexpr size_t OFF_WFI = OFF_WOUT + AL((size_t)1024 * 1024 * 2);
constexpr size_t OFF_WFO = OFF_WFI + AL((size_t)5632 * 1024 * 2);
constexpr size_t OFF_WSGU = OFF_WFO + AL((size_t)1024 * 2816 * 2);
constexpr size_t WS_END = OFF_WSGU + AL((size_t)6 * 128 * 128 * 2);
constexpr size_t OFF_HID = OFF_P;
constexpr size_t OFF_CTL = WS_END;
constexpr size_t WS_TOTAL = WS_END + 4096;

#define LDS_BYTES 81920
#define ABL_FFN 0
#define ABL_MIX 0
#ifndef REPEAT_MASK
#define REPEAT_MASK 0
#endif

#define ABL_BR -1

struct Params {
  const float* in[38];
  float* out;
  char* ws;
  int ph_lo, ph_hi;
  int nblk, pad0;
};

__device__ __forceinline__ NOPK int tidx() { int t = __builtin_amdgcn_workitem_id_x(); asm volatile("" : "+v"(t)); return t; }
__device__ __forceinline__ NOPK char* wsp(const Params& p) { char* w = p.ws; asm volatile("" : "+s"(w)); return w; }
__device__ __forceinline__ NOPK float sigm(float x) { return __builtin_amdgcn_rcpf(1.f + __expf(-x)); }
__device__ __forceinline__ NOPK float silu_f(float x) { return x * sigm(x); }
__device__ __forceinline__ NOPK float gelu_f(float x) { return x * sigm(1.5957691216f * (x + 0.044715f * x * x * x)); }
__device__ __forceinline__ NOPK unsigned pack2(float a, float b) {
  union { bf16 h[2]; unsigned u; } P; P.h[0] = (bf16)a; P.h[1] = (bf16)b; return P.u;
}
__device__ __forceinline__ NOPK f32x16 mfma32(bf16x8 a, bf16x8 b, f32x16 c) {
  return __builtin_amdgcn_mfma_f32_32x32x16_bf16(a, b, c, 0, 0, 0);
}
__device__ __forceinline__ NOPK f32x16 zero16() { f32x16 z; for (int i = 0; i < 16; ++i) z[i] = 0.f; asm volatile("" : "+v"(z)); return z; }
__device__ __forceinline__ NOPK f32x16 splat16(float v) { f32x16 z; for (int i = 0; i < 16; ++i) z[i] = v; asm volatile("" : "+v"(z)); return z; }
__device__ __forceinline__ NOPK float wave_sum(float v) {
  for (int o = 32; o > 0; o >>= 1) v += __shfl_xor(v, o);
  return v;
}

typedef unsigned int u32x4_t __attribute__((ext_vector_type(4)));
typedef __attribute__((address_space(1))) const u32x4_t g_u32x4;
__device__ __forceinline__ NOPK uint4 ldg16(const void* p) {
  u32x4_t v = *(g_u32x4*)p;
  uint4 r; r.x = v.x; r.y = v.y; r.z = v.z; r.w = v.w; return r;
}
template <class T> __device__ __forceinline__ NOPK void gst(T* p, T v) { *(__attribute__((address_space(1))) T*)p = v; }
template <class T> __device__ __forceinline__ NOPK T gld(const T* p) { return *(__attribute__((address_space(1))) const T*)p; }
#define BKK 64
#define LDK 72
template <int NI>
__device__ __forceinline__ NOPK void gemm_core_t(f32x16 (&acc)[2][NI], const bf16* __restrict__ A, int lda,
                                            const bf16* __restrict__ B, int ldb, int K, char* smem) {
  bf16* As = (bf16*)smem;
  bf16* Bs = As + 2 * 128 * LDK;
  const int tid = tidx(), lane = tid & 63, w = tid >> 6, wm = w >> 1, wn = w & 1;
  const int r = lane & 31, h = lane >> 5;
  const int nk = K / BKK;
  const int srow = tid >> 3, spart = tid & 7;
  const bf16* ag = A + (size_t)srow * lda + spart * 8;
  const bf16* bg = B + (size_t)srow * ldb + spart * 8;
  uint4 pa0, pa1, pa2, pa3, pb0, pb1, pb2, pb3;
  uint4 qa0, qa1, qa2, qa3, qb0, qb1, qb2, qb3;
#define GLOAD(S, ko) \
  S##a0 = ldg16(ag + (ko)); S##a1 = ldg16(ag + (size_t)32 * lda + (ko)); \
  S##a2 = ldg16(ag + (size_t)64 * lda + (ko)); S##a3 = ldg16(ag + (size_t)96 * lda + (ko)); \
  S##b0 = ldg16(bg + (ko)); S##b1 = ldg16(bg + (size_t)32 * ldb + (ko)); \
  if (NI == 2) { S##b2 = ldg16(bg + (size_t)64 * ldb + (ko)); S##b3 = ldg16(bg + (size_t)96 * ldb + (ko)); }
#define SSTORE(S, buf) { \
  bf16* asw = As + (buf) * 128 * LDK + srow * LDK + spart * 8; bf16* bsw = Bs + (buf) * 128 * LDK + srow * LDK + spart * 8; \
  *(uint4*)(asw) = S##a0; *(uint4*)(asw + 32 * LDK) = S##a1; *(uint4*)(asw + 64 * LDK) = S##a2; *(uint4*)(asw + 96 * LDK) = S##a3; \
  *(uint4*)(bsw) = S##b0; *(uint4*)(bsw + 32 * LDK) = S##b1; \
  if (NI == 2) { *(uint4*)(bsw + 64 * LDK) = S##b2; *(uint4*)(bsw + 96 * LDK) = S##b3; } }
#define COMPUTE(buf) { \
  const bf16* as = As + (buf) * 128 * LDK + (wm * 64 + r) * LDK + h * 8; \
  const bf16* bs = Bs + (buf) * 128 * LDK + (wn * 32 * NI + r) * LDK + h * 8; \
  _Pragma("unroll") for (int ks = 0; ks < BKK / 16; ++ks) { \
    bf16x8 a0 = *(const bf16x8*)(as + ks * 16); bf16x8 a1 = *(const bf16x8*)(as + 32 * LDK + ks * 16); \
    _Pragma("unroll") for (int ni = 0; ni < NI; ++ni) { \
      bf16x8 b0 = *(const bf16x8*)(bs + ni * 32 * LDK + ks * 16); \
      acc[0][ni] = mfma32(a0, b0, acc[0][ni]); acc[1][ni] = mfma32(a1, b0, acc[1][ni]); } } }
  GLOAD(p, 0)
  GLOAD(q, BKK)
  for (int kt = 0; kt < nk; kt += 2) {
    SSTORE(p, 0)
    __syncthreads();
    if (kt + 2 < nk) { GLOAD(p, (kt + 2) * BKK) }
    COMPUTE(0)
    SSTORE(q, 1)
    __syncthreads();
    if (kt + 3 < nk) { GLOAD(q, (kt + 3) * BKK) }
    COMPUTE(1)
  }
  __syncthreads();
#undef GLOAD
#undef SSTORE
#undef COMPUTE
}
__device__ __forceinline__ NOPK void gemm_core(f32x16 (&acc)[2][2], const bf16* __restrict__ A, int lda,
                                          const bf16* __restrict__ B, int ldb, int K, char* smem) {
  gemm_core_t<2>(acc, A, lda, B, ldb, K, smem);
}
#define LDK2 40
__device__ __forceinline__ NOPK void gemm_core_big(f32x16 (&acc)[4][2], const bf16* __restrict__ A, int lda,
                                                   const bf16* __restrict__ B, int ldb, int K, char* smem) {
  bf16* As = (bf16*)smem;
  bf16* Bs = As + 2 * 256 * LDK2;
  const int tid = tidx(), lane = tid & 63, w = tid >> 6, wm = w >> 1, wn = w & 1;
  const int r = lane & 31, h = lane >> 5;
  const int nk = K / 32;
  const int srow = tid >> 2, spart = tid & 3;
  const bf16* ag = A + (size_t)srow * lda + spart * 8;
  const bf16* bg = B + (size_t)srow * ldb + spart * 8;
  uint4 pa0, pa1, pa2, pa3, pb0, pb1;
  uint4 qa0, qa1, qa2, qa3, qb0, qb1;
#define GLOAD(S, ko) \
  S##a0 = ldg16(ag + (ko)); S##a1 = ldg16(ag + (size_t)64 * lda + (ko)); \
  S##a2 = ldg16(ag + (size_t)128 * lda + (ko)); S##a3 = ldg16(ag + (size_t)192 * lda + (ko)); \
  S##b0 = ldg16(bg + (ko)); S##b1 = ldg16(bg + (size_t)64 * ldb + (ko));
#define SSTORE(S, buf) { \
  bf16* asw = As + (buf) * 256 * LDK2 + srow * LDK2 + spart * 8; bf16* bsw = Bs + (buf) * 128 * LDK2 + srow * LDK2 + spart * 8; \
  *(uint4*)(asw) = S##a0; *(uint4*)(asw + 64 * LDK2) = S##a1; *(uint4*)(asw + 128 * LDK2) = S##a2; *(uint4*)(asw + 192 * LDK2) = S##a3; \
  *(uint4*)(bsw) = S##b0; *(uint4*)(bsw + 64 * LDK2) = S##b1; }
#define COMPUTE(buf) { \
  const bf16* as = As + (buf) * 256 * LDK2 + (wm * 128 + r) * LDK2 + h * 8; \
  const bf16* bs = Bs + (buf) * 128 * LDK2 + (wn * 64 + r) * LDK2 + h * 8; \
  _Pragma("unroll") for (int ks = 0; ks < 2; ++ks) { \
    bf16x8 b0 = *(const bf16x8*)(bs + ks * 16); bf16x8 b1 = *(const bf16x8*)(bs + 32 * LDK2 + ks * 16); \
    _Pragma("unroll") for (int mi = 0; mi < 4; ++mi) { \
      bf16x8 a = *(const bf16x8*)(as + mi * 32 * LDK2 + ks * 16); \
      acc[mi][0] = mfma32(a, b0, acc[mi][0]); acc[mi][1] = mfma32(a, b1, acc[mi][1]); } } }
  GLOAD(p, 0)
  GLOAD(q, 32)
  for (int kt = 0; kt < nk; kt += 2) {
    SSTORE(p, 0)
    __syncthreads();
    if (kt + 2 < nk) { GLOAD(p, (kt + 2) * 32) }
    COMPUTE(0)
    SSTORE(q, 1)
    __syncthreads();
    if (kt + 3 < nk) { GLOAD(q, (kt + 3) * 32) }
    COMPUTE(1)
  }
  __syncthreads();
#undef GLOAD
#undef SSTORE
#undef COMPUTE
}
struct Stage6 { uint4 a0, a1, a2, a3, b0, b1; };
__device__ __forceinline__ NOPK void chain_load(Stage6& s, const bf16* ag, int lda, const bf16* bg, int ldb, int ko) {
  s.a0 = ldg16(ag + ko); s.a1 = ldg16(ag + (size_t)32 * lda + ko); s.a2 = ldg16(ag + (size_t)64 * lda + ko); s.a3 = ldg16(ag + (size_t)96 * lda + ko);
  s.b0 = ldg16(bg + ko); s.b1 = ldg16(bg + (size_t)32 * ldb + ko);
}
__device__ __forceinline__ NOPK void gemm_chain(f32x16 (&acc)[2][1], Stage6& P, Stage6& Q, const bf16* __restrict__ A, int lda,
                                                const bf16* __restrict__ B, int ldb, int K, const bf16* __restrict__ nA, int nlda,
                                                const bf16* __restrict__ nB, int nldb, char* smem) {
  bf16* As = (bf16*)smem;
  bf16* Bs = As + 2 * 128 * LDK;
  const int tid = tidx(), lane = tid & 63, w = tid >> 6, wm = w >> 1, wn = w & 1;
  const int r = lane & 31, h = lane >> 5;
  const int nk = K / BKK;
  const int srow = tid >> 3, spart = tid & 7;
  const bf16* ag = A + (size_t)srow * lda + spart * 8;
  const bf16* bg = B + (size_t)srow * ldb + spart * 8;
  const bf16* nag = nA + (size_t)srow * nlda + spart * 8;
  const bf16* nbg = nB + (size_t)srow * nldb + spart * 8;
#define CSTORE(S, buf) { \
  bf16* asw = As + (buf) * 128 * LDK + srow * LDK + spart * 8; bf16* bsw = Bs + (buf) * 128 * LDK + srow * LDK + spart * 8; \
  *(uint4*)(asw) = S.a0; *(uint4*)(asw + 32 * LDK) = S.a1; *(uint4*)(asw + 64 * LDK) = S.a2; *(uint4*)(asw + 96 * LDK) = S.a3; \
  *(uint4*)(bsw) = S.b0; *(uint4*)(bsw + 32 * LDK) = S.b1; }
#define CCOMPUTE(buf) { \
  const bf16* as = As + (buf) * 128 * LDK + (wm * 64 + r) * LDK + h * 8; \
  const bf16* bs = Bs + (buf) * 128 * LDK + (wn * 32 + r) * LDK + h * 8; \
  _Pragma("unroll") for (int ks = 0; ks < BKK / 16; ++ks) { \
    bf16x8 a0 = *(const bf16x8*)(as + ks * 16); bf16x8 a1 = *(const bf16x8*)(as + 32 * LDK + ks * 16); \
    bf16x8 b0 = *(const bf16x8*)(bs + ks * 16); \
    acc[0][0] = mfma32(a0, b0, acc[0][0]); acc[1][0] = mfma32(a1, b0, acc[1][0]); } }
  for (int kt = 0; kt < nk; kt += 2) {
    CSTORE(P, 0)
    __syncthreads();
    if (kt + 2 < nk) chain_load(P, ag, lda, bg, ldb, (kt + 2) * BKK);
    else if (nA) chain_load(P, nag, nlda, nbg, nldb, 0);
    CCOMPUTE(0)
    CSTORE(Q, 1)
    __syncthreads();
    if (kt + 3 < nk) chain_load(Q, ag, lda, bg, ldb, (kt + 3) * BKK);
    else if (nA) chain_load(Q, nag, nlda, nbg, nldb, BKK);
    CCOMPUTE(1)
  }
  __syncthreads();
#undef CSTORE
#undef CCOMPUTE
}

template <class F>
__device__ __forceinline__ NOPK void gemm_epi(const f32x16 (&acc)[2][2], F f) {
  const int lane = tidx() & 63, w = tidx() >> 6, wm = w >> 1, wn = w & 1, r = lane & 31, h = lane >> 5;
#pragma unroll
  for (int mi = 0; mi < 2; ++mi)
#pragma unroll
    for (int ni = 0; ni < 2; ++ni)
#pragma unroll
      for (int reg = 0; reg < 16; ++reg) {
        int row = wm * 64 + mi * 32 + (reg & 3) + 8 * (reg >> 2) + 4 * h;
        int col = wn * 64 + ni * 32 + r;
        f(row, col, acc[mi][ni][reg]);
      }
}
__device__ __forceinline__ NOPK void zero_acc(f32x16 (&acc)[2][2]) {
  acc[0][0] = zero16(); acc[0][1] = zero16(); acc[1][0] = zero16(); acc[1][1] = zero16();
}

template <class CM>
__device__ __forceinline__ NOPK void conv_tile(const float* __restrict__ src, int ld, int k0, int n0, bf16* __restrict__ dst, int dstld,
                                          const float* __restrict__ kscale, CM cmap, float* lds) {
  const int tid = tidx();
  {
    const int nn = tid & 63;
    const int sc = cmap(n0 + nn);
#pragma unroll 4
    for (int i = 0; i < 16; ++i) {
      int kk = (tid >> 6) + 4 * i;
      float v = sc >= 0 ? src[(size_t)(k0 + kk) * ld + sc] : 0.f;
      if (kscale) v *= kscale[k0 + kk];
      lds[kk * 65 + nn] = v;
    }
  }
  __syncthreads();
  {
    const int kk2 = (tid & 31) * 2;
#pragma unroll 4
    for (int i = 0; i < 8; ++i) {
      int nn = (tid >> 5) + 8 * i;
      unsigned u = pack2(lds[kk2 * 65 + nn], lds[(kk2 + 1) * 65 + nn]);
      *(unsigned*)(dst + (size_t)(n0 + nn) * dstld + k0 + kk2) = u;
    }
  }
  __syncthreads();
}

__device__ NOPK void wprep_item(const Params& p, int l, int it, char* smem) {
  float* lds = (float*)smem;
  char* ws = wsp(p);
  constexpr int T_WIN = 46 * 16, T_WG = 64 * 16, T_WUQ = 10 * 6, T_WUKV = 12 * 4, T_WGLU = 6 * 6, T_WBR = 4 * 16 * 6,
                T_WOUT = 16 * 16, T_WFI = 88 * 16, T_WFO = 16 * 44;
  if (it < T_WIN) {
    int nt = it / 16, kt = it % 16;
    conv_tile(p.in[8] + (size_t)l * 1024 * 6956, 6956, kt * 64, nt * 64, (bf16*)(ws + OFF_WIN), 1024, nullptr,
              [](int n) NOPK { return n < 2188 ? n : (n < 2192 ? -1 : (n < 2864 ? n - 4 : -1)); }, lds);
    return;
  }
  it -= T_WIN;
  if (it < T_WG) {
    int nt = it / 16, kt = it % 16;
    conv_tile(p.in[8] + (size_t)l * 1024 * 6956, 6956, kt * 64, nt * 64, (bf16*)(ws + OFF_WG), 1024, nullptr,
              [](int n) NOPK { return 2860 + n; }, lds);
    return;
  }
  it -= T_WG;
  if (it < T_WUQ) {
    int nt = it / 6, kt = it % 6;
    conv_tile(p.in[29] + (size_t)l * 384 * 576, 576, kt * 64, nt * 64, (bf16*)(ws + OFF_WUQ), 384, p.in[28] + l * 384,
              [](int n) NOPK { return n < 576 ? n : -1; }, lds);
    return;
  }
  it -= T_WUQ;
  if (it < T_WUKV) {
    int nt = it / 4, kt = it % 4;
    conv_tile(p.in[31] + (size_t)l * 256 * 768, 768, kt * 64, nt * 64, (bf16*)(ws + OFF_WUKV), 256, p.in[30] + l * 256,
              [](int n) NOPK { return n; }, lds);
    return;
  }
  it -= T_WUKV;
  if (it < T_WGLU) {
    int nt = it / 6, kt = it % 6;
    conv_tile(p.in[17] + (size_t)l * 384 * 384, 384, kt * 64, nt * 64, (bf16*)(ws + OFF_WGLU), 384, nullptr,
              [](int n) NOPK { return n; }, lds);
    return;
  }
  it -= T_WGLU;
  if (it < T_WBR) {
    int br = it / 96, rem = it % 96, nt = rem / 6, kt = rem % 6;
    conv_tile(p.in[34] + ((size_t)l * 4 + br) * 384 * 1024, 1024, kt * 64, nt * 64, (bf16*)(ws + OFF_WBR) + (size_t)br * 1024 * 384, 384,
              br == 2 ? p.in[27] + l * 384 : nullptr, [](int n) NOPK { return n; }, lds);
    return;
  }
  it -= T_WBR;
  if (it < T_WOUT) {
    int nt = it / 16, kt = it % 16;
    conv_tile(p.in[35] + (size_t)l * 1024 * 1024, 1024, kt * 64, nt * 64, (bf16*)(ws + OFF_WOUT), 1024, nullptr,
              [](int n) NOPK { return n; }, lds);
    return;
  }
  it -= T_WOUT;
  if (it < T_WFI) {
    int nt = it / 16, kt = it % 16;
    conv_tile(p.in[36] + (size_t)l * 1024 * 5632, 5632, kt * 64, nt * 64, (bf16*)(ws + OFF_WFI), 1024, nullptr,
              [](int n) NOPK { int tile = n >> 7, wn = (n >> 6) & 1, sub = (n >> 5) & 1, c = n & 31; return sub * FFH + tile * 64 + wn * 32 + c; }, lds);
    return;
  }
  it -= T_WFI;
  if (it < T_WFO) {
    int nt = it / 44, kt = it % 44;
    conv_tile(p.in[37] + (size_t)l * FFH * 1024, 1024, kt * 64, nt * 64, (bf16*)(ws + OFF_WFO), FFH, nullptr,
              [](int n) NOPK { return n; }, lds);
    return;
  }
  it -= T_WFO;
  if (it < 96) {
    const float* src = p.in[20] + (size_t)l * 6 * 128 * 128;
    bf16* dst = (bf16*)(ws + OFF_WSGU);
    int base = it * 1024 + tidx() * 4;
    float4 v = *(const float4*)(src + base);
    uint2 u; u.x = pack2(v.x, v.y); u.y = pack2(v.z, v.w);
    *(uint2*)(dst + base) = u;
    return;
  }
  it -= 96;
  if (it < 48) {
    int d = it / 24, g = it % 24;
    int pp = tidx() & 63, part = tidx() >> 6;
    size_t sg = (((size_t)l * 2 + d) * 24 + g) * 64 + pp;
    float a_re = p.in[9][sg], a_im = p.in[10][sg];
    float dt = expf(p.in[15][((size_t)l * 2 + d) * 24 + g]);
    float mag = expf(a_re * dt), ang = a_im * dt;
    float ab_re = mag * cosf(ang), ab_im = mag * sinf(ang);
    float den = a_re * a_re + a_im * a_im;
    float f_re = ((ab_re - 1.f) * a_re + ab_im * a_im) / den;
    float f_im = (ab_im * a_re - (ab_re - 1.f) * a_im) / den;
    bf16* bb = (bf16*)(ws + OFF_S5BB) + (size_t)(d * 24 + g) * 128 * 16;
    bf16* cm = (bf16*)(ws + OFF_S5CM) + (size_t)(d * 24 + g) * 16 * 128;
    for (int c = part * 4; c < part * 4 + 4; ++c) {
      float b_re = p.in[11][sg * 16 + c], b_im = p.in[12][sg * 16 + c];
      bb[pp * 16 + c] = (bf16)(f_re * b_re - f_im * b_im);
      bb[(64 + pp) * 16 + c] = (bf16)(f_re * b_im + f_im * b_re);
      size_t ci = ((((size_t)l * 2 + d) * 24 + g) * 16 + c) * 64 + pp;
      cm[c * 128 + pp] = (bf16)(p.in[13][ci]);
      cm[c * 128 + 64 + pp] = (bf16)(-p.in[14][ci]);
    }
    if (part == 0) {
      float wr = ab_re, wi = ab_im;
      for (int s = 0; s < 6; ++s) { float nr = wr * wr - wi * wi, ni = 2.f * wr * wi; wr = nr; wi = ni; }
      float4 o; o.x = ab_re; o.y = ab_im; o.z = wr; o.w = wi;
      ((float4*)(ws + OFF_S5AB))[(d * 24 + g) * 64 + pp] = o;
    }
    return;
  }
}
#define WPREP_ITEMS (46 * 16 + 64 * 16 + 60 + 48 + 36 + 384 + 256 + 88 * 16 + 16 * 44 + 96 + 48)

__device__ NOPK void norm_item(const Params& p, int l, int which, int item) {
  const int w = tidx() >> 6, lane = tidx() & 63;
  const int row = item * 4 + w;
  const int b = row / SEG, j = row % SEG;
  const int v = j < CTXL ? 2 : b;
  const float* x = (const float*)(wsp(p) + OFF_X) + (size_t)row * DM;
  const float* g = p.in[which ? 7 : 6] + l * DM;
  const float* mod = (const float*)(wsp(p) + OFF_MOD) + (size_t)(l * 3 + v) * 6144 + which * 3072;
  float4 xv[4];
  float ss = 0.f;
#pragma unroll
  for (int i = 0; i < 4; ++i) {
    xv[i] = ((const float4*)x)[lane + 64 * i];
    ss += xv[i].x * xv[i].x + xv[i].y * xv[i].y + xv[i].z * xv[i].z + xv[i].w * xv[i].w;
  }
  ss = wave_sum(ss);
  const float rinv = rsqrtf(ss * (1.f / 1024.f) + 1e-6f);
  bf16* hout = (bf16*)(wsp(p) + OFF_H) + (size_t)row * DM;
#pragma unroll
  for (int i = 0; i < 4; ++i) {
    int k = (lane + 64 * i) * 4;
    float4 gv = *(const float4*)(g + k), sh = *(const float4*)(mod + k), sc = *(const float4*)(mod + 1024 + k);
    float y0 = xv[i].x * rinv * gv.x * (1.f + sc.x) + sh.x;
    float y1 = xv[i].y * rinv * gv.y * (1.f + sc.y) + sh.y;
    float y2 = xv[i].z * rinv * gv.z * (1.f + sc.z) + sh.z;
    float y3 = xv[i].w * rinv * gv.w * (1.f + sc.w) + sh.w;
    uint2 u; u.x = pack2(y0, y1); u.y = pack2(y2, y3);
    *(uint2*)(hout + k) = u;
  }
}

__device__ __forceinline__ NOPK void row_rms(const bf16* base, int ld, int ncols, float eps, float* rs) {
  const int row = tidx() >> 1, half = tidx() & 1;
  const int per = ncols / 2;
  const bf16* src = base + (size_t)row * ld + half * per;
  float ss = 0.f;
#pragma unroll 8
  for (int i = 0; i < per; i += 8) {
    bf16x8 v = *(const bf16x8*)(src + i);
#pragma unroll
    for (int e = 0; e < 8; ++e) { float f = (float)v[e]; ss += f * f; }
  }
  ss += __shfl_xor(ss, 1);
  if (half == 0) rs[row] = rsqrtf(ss / (float)ncols + eps);
  __syncthreads();
}

__device__ NOPK void sgu_item(const Params& p, int l, int item, char* smem) {
  const int head = item % 6, c = (item / 6) % 66, b = item / 396;
  const int R0 = b * SEG + c * 128;
  const bf16* P = (const bf16*)(wsp(p) + OFF_P);
  bf16* vnT = (bf16*)smem;
  float* mu = (float*)(smem + 64 * 136 * 2);
  float* rstd = mu + 128;
  const int tid = tidx();
  {
    const int row = tid >> 1, half = tid & 1;
    const bf16* src = P + (size_t)(R0 + row) * PLD + PC_SGU + 384 + half * 192;
    float s1 = 0.f, s2 = 0.f;
#pragma unroll 8
    for (int i = 0; i < 192; i += 8) {
      bf16x8 v = *(const bf16x8*)(src + i);
#pragma unroll
      for (int e = 0; e < 8; ++e) { float f = gelu_f((float)v[e]); s1 += f; s2 += f * f; }
    }
    s1 += __shfl_xor(s1, 1); s2 += __shfl_xor(s2, 1);
    float m = s1 * (1.f / 384.f);
    float var = s2 * (1.f / 384.f) - m * m;
    if (half == 0) { mu[row] = m; rstd[row] = rsqrtf(fmaxf(var, 0.f) + 1e-5f); }
  }
  __syncthreads();
  {
    const int row = tid >> 1, half = tid & 1;
    const bf16* src = P + (size_t)(R0 + row) * PLD + PC_SGU + 384 + head * 64 + half * 32;
    const float* lg = p.in[18] + l * 384 + head * 64 + half * 32;
    const float* lb = p.in[19] + l * 384 + head * 64 + half * 32;
    const float m = mu[row], rs = rstd[row];
#pragma unroll
    for (int i = 0; i < 32; i += 8) {
      bf16x8 v = *(const bf16x8*)(src + i);
#pragma unroll
      for (int e = 0; e < 8; ++e) {
        float f = (gelu_f((float)v[e]) - m) * rs * lg[i + e] + lb[i + e];
        vnT[(half * 32 + i + e) * 136 + row] = (bf16)f;
      }
    }
  }
  __syncthreads();
  const int lane = tid & 63, w = tid >> 6, r = lane & 31, h = lane >> 5;
  f32x16 acc[2] = {zero16(), zero16()};
  const bf16* Ws = (const bf16*)(wsp(p) + OFF_WSGU) + (size_t)head * 128 * 128 + (size_t)(32 * w + r) * 128 + 8 * h;
#pragma unroll
  for (int ks = 0; ks < 8; ++ks) {
    bf16x8 a = *(const bf16x8*)(Ws + 16 * ks);
    bf16x8 b0 = *(const bf16x8*)(vnT + r * 136 + 16 * ks + 8 * h);
    bf16x8 b1 = *(const bf16x8*)(vnT + (32 + r) * 136 + 16 * ks + 8 * h);
    acc[0] = mfma32(a, b0, acc[0]);
    acc[1] = mfma32(a, b1, acc[1]);
  }
  const float* bsp = p.in[21] + ((size_t)l * 6 + head) * 128;
  bf16* yo = (bf16*)(wsp(p) + OFF_YB) + (size_t)1 * TROWS * 384;
#pragma unroll
  for (int dt = 0; dt < 2; ++dt)
#pragma unroll
    for (int reg = 0; reg < 16; ++reg) {
      int t = 32 * w + (reg & 3) + 8 * (reg >> 2) + 4 * h;
      int d = 32 * dt + r;
      float mixed = acc[dt][reg] + bsp[t];
      float u = gelu_f((float)P[(size_t)(R0 + t) * PLD + PC_SGU + head * 64 + d]);
      yo[(size_t)(R0 + t) * 384 + head * 64 + d] = (bf16)(u * mixed);
    }
  __syncthreads();
}

__device__ __forceinline__ NOPK void s5_wave(const Params& p, int b, int kk, int d, int g, bf16* hl, float& sre, float& sim, bool writeH) {
  const int lane = tidx() & 63, r = lane & 31, h = lane >> 5;
  const int R0 = b * SEG + kk * 64;
  const bf16* P = (const bf16*)(wsp(p) + OFF_P);
  const bf16* bb = (const bf16*)(wsp(p) + OFF_S5BB) + (size_t)(d * 24 + g) * 128 * 16;
#pragma unroll
  for (int mt = 0; mt < 2; ++mt) {
    bf16x8 a = *(const bf16x8*)(P + (size_t)(R0 + 32 * mt + r) * PLD + PC_S5 + g * 16 + 8 * h);
#pragma unroll
    for (int nt = 0; nt < 4; ++nt) {
      bf16x8 bv = *(const bf16x8*)(bb + (32 * nt + r) * 16 + 8 * h);
      f32x16 acc = mfma32(a, bv, zero16());
#pragma unroll
      for (int reg = 0; reg < 16; ++reg) {
        int t = 32 * mt + (reg & 3) + 8 * (reg >> 2) + 4 * h;
        hl[t * 136 + 32 * nt + r] = (bf16)acc[reg];
      }
    }
  }
  __syncthreads();
  const float4 ab = ((const float4*)(wsp(p) + OFF_S5AB))[(d * 24 + g) * 64 + lane];
#pragma unroll 1
  for (int s0 = 0; s0 < 64; s0 += 8) {
    bf16 vr[8], vi[8];
#pragma unroll
    for (int j = 0; j < 8; ++j) {
      int t = d ? 63 - (s0 + j) : s0 + j;
      vr[j] = hl[t * 136 + lane]; vi[j] = hl[t * 136 + 64 + lane];
    }
#pragma unroll
    for (int j = 0; j < 8; ++j) {
      int t = d ? 63 - (s0 + j) : s0 + j;
      float nre = ab.x * sre - ab.y * sim + (float)vr[j];
      float nim = ab.x * sim + ab.y * sre + (float)vi[j];
      sre = nre; sim = nim;
      if (writeH) { hl[t * 136 + lane] = (bf16)sre; hl[t * 136 + 64 + lane] = (bf16)sim; }
    }
  }
  __syncthreads();
}
__device__ NOPK void s5a_item(const Params& p, int item, char* smem) {
  const int quad = item % 6, d = (item / 6) & 1, kk = (item / 12) % 132, b = item / (12 * 132);
  const int w = tidx() >> 6, lane = tidx() & 63;
  const int g = quad * 4 + w;
  bf16* hl = (bf16*)smem + w * 64 * 136;
  float sre = 0.f, sim = 0.f;
  s5_wave(p, b, kk, d, g, hl, sre, sim, false);
  float2* loc = (float2*)(wsp(p) + OFF_S5LOC);
  loc[((size_t)((b * 2 + d) * 132 + kk) * 24 + g) * 64 + lane] = make_float2(sre, sim);
  __syncthreads();
}
__device__ NOPK void s5b_item(const Params& p, int l, int item, char* smem) {
  const int quad = item % 6, kk = (item / 6) % 132, b = item / (6 * 132);
  const int w = tidx() >> 6, lane = tidx() & 63, r = lane & 31, h = lane >> 5;
  const int g = quad * 4 + w;
  bf16* hl = (bf16*)smem + w * 64 * 136;
  const float2* loc = (const float2*)(wsp(p) + OFF_S5LOC);
  f32x16 yacc[2] = {zero16(), zero16()};
  for (int d = 0; d < 2; ++d) {
    const float4 ab = ((const float4*)(wsp(p) + OFF_S5AB))[(d * 24 + g) * 64 + lane];
    float sre = 0.f, sim = 0.f;
    const int npos = d ? (kk < 4 ? 3 - kk : 135 - kk) : kk;
    const float2* locb = loc + ((size_t)((b * 2 + d) * 132) * 24 + g) * 64 + lane;
    int o = 0;
    for (; o + 16 <= npos; o += 16) {
      float2 s0, s1, s2, s3, s4, s5, s6, s7, t0, t1, t2, t3, t4, t5, t6, t7;
#define LOCLD(j) locb[(size_t)(d ? ((o + j) < 4 ? 3 - (o + j) : 135 - (o + j)) : (o + j)) * 24 * 64]
#define CSTEP(s) { float nre = ab.z * sre - ab.w * sim + s.x; float nim = ab.z * sim + ab.w * sre + s.y; sre = nre; sim = nim; }
      s0 = LOCLD(0); s1 = LOCLD(1); s2 = LOCLD(2); s3 = LOCLD(3); s4 = LOCLD(4); s5 = LOCLD(5); s6 = LOCLD(6); s7 = LOCLD(7);
      t0 = LOCLD(8); t1 = LOCLD(9); t2 = LOCLD(10); t3 = LOCLD(11); t4 = LOCLD(12); t5 = LOCLD(13); t6 = LOCLD(14); t7 = LOCLD(15);
      CSTEP(s0) CSTEP(s1) CSTEP(s2) CSTEP(s3) CSTEP(s4) CSTEP(s5) CSTEP(s6) CSTEP(s7)
      CSTEP(t0) CSTEP(t1) CSTEP(t2) CSTEP(t3) CSTEP(t4) CSTEP(t5) CSTEP(t6) CSTEP(t7)
#undef LOCLD
#undef CSTEP
    }
    for (; o + 8 <= npos; o += 8) {
      float2 s0, s1, s2, s3, s4, s5, s6, s7;
#define LOCLD(j) locb[(size_t)(d ? ((o + j) < 4 ? 3 - (o + j) : 135 - (o + j)) : (o + j)) * 24 * 64]
      s0 = LOCLD(0); s1 = LOCLD(1); s2 = LOCLD(2); s3 = LOCLD(3); s4 = LOCLD(4); s5 = LOCLD(5); s6 = LOCLD(6); s7 = LOCLD(7);
#define CSTEP(s) { float nre = ab.z * sre - ab.w * sim + s.x; float nim = ab.z * sim + ab.w * sre + s.y; sre = nre; sim = nim; }
      CSTEP(s0) CSTEP(s1) CSTEP(s2) CSTEP(s3) CSTEP(s4) CSTEP(s5) CSTEP(s6) CSTEP(s7)
    }
    for (; o < npos; ++o) {
      float2 s = LOCLD(0);
      CSTEP(s)
    }
#undef LOCLD
#undef CSTEP
    s5_wave(p, b, kk, d, g, hl, sre, sim, true);
    const bf16* cm = (const bf16*)(wsp(p) + OFF_S5CM) + (size_t)(d * 24 + g) * 16 * 128;
#pragma unroll
    for (int ks = 0; ks < 8; ++ks) {
      bf16x8 bv;
#pragma unroll
      for (int e = 0; e < 8; ++e) bv[e] = (bf16)0.f;
      if (r < 16) bv = *(const bf16x8*)(cm + r * 128 + 16 * ks + 8 * h);
      bf16x8 a0 = *(const bf16x8*)(hl + r * 136 + 16 * ks + 8 * h);
      bf16x8 a1 = *(const bf16x8*)(hl + (32 + r) * 136 + 16 * ks + 8 * h);
      yacc[0] = mfma32(a0, bv, yacc[0]);
      yacc[1] = mfma32(a1, bv, yacc[1]);
    }
    __syncthreads();
  }
  if (r < 16) {
    const int R0 = b * SEG + kk * 64;
    const bf16* P = (const bf16*)(wsp(p) + OFF_P);
    bf16* ys = (bf16*)(wsp(p) + OFF_YS5);
    const int ch = g * 16 + r;
    const float dsk = p.in[16][l * 384 + ch];
#pragma unroll
    for (int mt = 0; mt < 2; ++mt)
#pragma unroll
      for (int reg = 0; reg < 16; ++reg) {
        int t = 32 * mt + (reg & 3) + 8 * (reg >> 2) + 4 * h;
        float u = (float)P[(size_t)(R0 + t) * PLD + PC_S5 + ch];
        float y = yacc[mt][reg] + dsk * u;
        ys[(size_t)(R0 + t) * 384 + ch] = (bf16)gelu_f(y);
      }
  }
  __syncthreads();
}

__device__ __forceinline__ NOPK void ssd_dt(const Params& p, int l, int R0, int hh, float* dts, float* das, float* acs) {
  const int tid = tidx();
  const bf16* P = (const bf16*)(wsp(p) + OFF_P);
  {
    int t = tid & 127, d = tid >> 7;
    float raw = (float)P[(size_t)(R0 + t) * PLD + PC_DT + d * 6 + hh] + p.in[25][(l * 2 + d) * 6 + hh];
    float dt = raw > 20.f ? raw : log1pf(expf(raw));
    float A = -expf(p.in[24][(l * 2 + d) * 6 + hh]);
    dts[d * 128 + t] = dt;
    das[d * 128 + t] = dt * A;
  }
  __syncthreads();
  if (tid < 128) {
    int d = tid >> 6, lane = tid & 63;
    float a0 = das[d * 128 + 2 * lane], a1 = das[d * 128 + 2 * lane + 1];
    float s = a0 + a1;
    for (int o = 1; o < 64; o <<= 1) { float n = __shfl_up(s, o); if (lane >= o) s += n; }
    acs[d * 128 + 2 * lane + 1] = s;
    acs[d * 128 + 2 * lane] = s - a1;
  }
  __syncthreads();
}
__device__ __forceinline__ NOPK void ssd_load_tile(const Params& p, int l, int R0, int ch0, bf16* dst, int stride, bool transposed) {
  const bf16* P = (const bf16*)(wsp(p) + OFF_P);
  const float* cw = p.in[22] + (size_t)l * 3 * 640;
  const float* cb = p.in[23] + (size_t)l * 640;
#pragma unroll
  for (int it = 0; it < 4; ++it) {
    int idx = tidx() + 256 * it;
    int t = idx >> 3, cgp = idx & 7;
    int ch = ch0 + cgp * 8;
    int row = R0 + t, j = row % SEG;
    bool hp = (j != 0) && (j != CTXL), hn = (j != CTXL - 1) && (j != SEG - 1);
    const bf16* src = P + (size_t)row * PLD + PC_XBC + ch;
    bf16x8 cur = *(const bf16x8*)src, prv, nxt;
#pragma unroll
    for (int e = 0; e < 8; ++e) { prv[e] = (bf16)0.f; nxt[e] = (bf16)0.f; }
    if (hp) prv = *(const bf16x8*)(src - PLD);
    if (hn) nxt = *(const bf16x8*)(src + PLD);
    bf16x8 o;
#pragma unroll
    for (int e = 0; e < 8; ++e) {
      float v = cw[ch + e] * (float)prv[e] + cw[640 + ch + e] * (float)cur[e] + cw[1280 + ch + e] * (float)nxt[e] + cb[ch + e];
      o[e] = (bf16)silu_f(v);
    }
    if (transposed) {
#pragma unroll
      for (int e = 0; e < 8; ++e) dst[(cgp * 8 + e) * stride + t] = o[e];
    } else {
      *(bf16x8*)(dst + t * stride + cgp * 8) = o;
    }
  }
}
__device__ NOPK void ssda_item(const Params& p, int l, int item, char* smem) {
  const int hh = item % 6, c = (item / 6) % 66, b = item / 396;
  const int R0 = b * SEG + c * 128;
  bf16* Xt = (bf16*)smem;
  bf16* Bt = Xt + 64 * 136;
  float* dts = (float*)(smem + 2 * 64 * 136 * 2);
  float* das = dts + 256;
  float* acs = das + 256;
  float* wgt = acs + 256;
  ssd_dt(p, l, R0, hh, dts, das, acs);
  ssd_load_tile(p, l, R0, hh * 64, Xt, 136, true);
  ssd_load_tile(p, l, R0, 384 + (hh / 3) * 64, Bt, 136, true);
  {
    int t = tidx() & 127, d = tidx() >> 7;
    float wv = d == 0 ? dts[t] * __expf(acs[127] - acs[t]) : dts[128 + t] * __expf(acs[128 + t] - das[128 + t]);
    wgt[d * 128 + t] = wv;
    if (tidx() < 2) {
      float* cd = (float*)(wsp(p) + OFF_SSDCD);
      cd[((b * 2 + tidx()) * 66 + c) * 6 + hh] = __expf(acs[tidx() * 128 + 127]);
    }
  }
  __syncthreads();
  const int lane = tidx() & 63, w = tidx() >> 6, r = lane & 31, h = lane >> 5;
  const int mt = w >> 1, nt = w & 1;
  float* S = (float*)(wsp(p) + OFF_SSDS);
  for (int d = 0; d < 2; ++d) {
    f32x16 acc = zero16();
#pragma unroll
    for (int ks = 0; ks < 8; ++ks) {
      bf16x8 a = *(const bf16x8*)(Xt + (32 * mt + r) * 136 + 16 * ks + 8 * h);
      bf16x8 bv = *(const bf16x8*)(Bt + (32 * nt + r) * 136 + 16 * ks + 8 * h);
#pragma unroll
      for (int e = 0; e < 8; ++e) a[e] = (bf16)((float)a[e] * wgt[d * 128 + 16 * ks + 8 * h + e]);
      acc = mfma32(a, bv, acc);
    }
    float* so = S + ((size_t)((b * 2 + d) * 66 + c) * 6 + hh) * 4096;
#pragma unroll
    for (int reg = 0; reg < 16; ++reg) {
      int pp = 32 * mt + (reg & 3) + 8 * (reg >> 2) + 4 * h;
      so[pp * 64 + 32 * nt + r] = acc[reg];
    }
  }
  __syncthreads();
}
__device__ NOPK void ssd_carry_item(const Params& p, int item) {
  int e = item * 256 + tidx();
  int pn = e & 4095, hh = (e >> 12) % 6, d = (e / (4096 * 6)) & 1, b = e / (4096 * 12);
  float* S = (float*)(wsp(p) + OFF_SSDS);
  const float* cd = (const float*)(wsp(p) + OFF_SSDCD);
  float s = 0.f;
  for (int o0 = 0; o0 < 66; o0 += 6) {
    float tmp[6], cdv[6]; size_t idx[6];
#pragma unroll
    for (int j = 0; j < 6; ++j) {
      int o = o0 + j;
      int c = d ? (o < 2 ? 1 - o : 67 - o) : o;
      idx[j] = ((size_t)((b * 2 + d) * 66 + c) * 6 + hh);
      tmp[j] = S[idx[j] * 4096 + pn];
      cdv[j] = cd[idx[j]];
    }
#pragma unroll
    for (int j = 0; j < 6; ++j) {
      S[idx[j] * 4096 + pn] = s;
      s = cdv[j] * s + tmp[j];
    }
  }
}
__device__ NOPK void ssdb_item(const Params& p, int l, int item, char* smem) {
  const int hh = item % 6, c = (item / 6) % 66, b = item / 396;
  const int R0 = b * SEG + c * 128;
  bf16* Xt = (bf16*)smem;
  bf16* Bs = Xt + 64 * 136;
  bf16* Cs = Bs + 128 * 72;
  float* dts = (float*)(smem + (64 * 136 + 2 * 128 * 72) * 2);
  float* das = dts + 256;
  float* acs = das + 256;
  ssd_dt(p, l, R0, hh, dts, das, acs);
  ssd_load_tile(p, l, R0, hh * 64, Xt, 136, true);
  ssd_load_tile(p, l, R0, 384 + (hh / 3) * 64, Bs, 72, false);
  ssd_load_tile(p, l, R0, 512 + (hh / 3) * 64, Cs, 72, false);
  __syncthreads();
  const int lane = tidx() & 63, w = tidx() >> 6, r = lane & 31, h = lane >> 5;
  bf16x8 cfrag[4];
#pragma unroll
  for (int ks = 0; ks < 4; ++ks) cfrag[ks] = *(const bf16x8*)(Cs + (32 * w + r) * 72 + 16 * ks + 8 * h);
  f32x16 yacc[2] = {zero16(), zero16()};
  const int lq = 32 * w + r;
  const float acf_l = acs[lq], aeb_l = acs[128 + lq] - das[128 + lq];
#pragma unroll 1
  for (int st = 0; st < 4; ++st) {
    f32x16 g = zero16();
#pragma unroll
    for (int ks = 0; ks < 4; ++ks) {
      bf16x8 a = *(const bf16x8*)(Bs + (32 * st + r) * 72 + 16 * ks + 8 * h);
      g = mfma32(a, cfrag[ks], g);
    }
    bf16x8 mf[2];
#pragma unroll
    for (int reg = 0; reg < 16; ++reg) {
      int s = 32 * st + (reg & 3) + 8 * (reg >> 2) + 4 * h;
      float m = 0.f;
      if (s <= lq) m += __expf(acf_l - acs[s]) * dts[s];
      if (s >= lq) m += __expf((acs[128 + s] - das[128 + s]) - aeb_l) * dts[128 + s];
      mf[reg >> 3][reg & 7] = (bf16)(g[reg] * m);
    }
#pragma unroll
    for (int k2 = 0; k2 < 2; ++k2)
#pragma unroll
      for (int pt = 0; pt < 2; ++pt) {
        const bf16* xs = Xt + (32 * pt + r) * 136 + 32 * st + 16 * k2 + 4 * h;
        bf16x4 lo = *(const bf16x4*)xs, hi = *(const bf16x4*)(xs + 8);
        bf16x8 bv;
#pragma unroll
        for (int e = 0; e < 4; ++e) { bv[e] = lo[e]; bv[4 + e] = hi[e]; }
        yacc[pt] = mfma32(mf[k2], bv, yacc[pt]);
      }
  }
  const float* S = (const float*)(wsp(p) + OFF_SSDS);
  for (int d = 0; d < 2; ++d) {
    const float* si = S + ((size_t)((b * 2 + d) * 66 + c) * 6 + hh) * 4096;
    f32x16 facc[2] = {zero16(), zero16()};
#pragma unroll
    for (int ks = 0; ks < 4; ++ks)
#pragma unroll
      for (int pt = 0; pt < 2; ++pt) {
        const float* sp = si + (32 * pt + r) * 64 + 16 * ks + 8 * h;
        float4 s0 = *(const float4*)sp, s1 = *(const float4*)(sp + 4);
        bf16x8 bv;
        bv[0] = (bf16)s0.x; bv[1] = (bf16)s0.y; bv[2] = (bf16)s0.z; bv[3] = (bf16)s0.w;
        bv[4] = (bf16)s1.x; bv[5] = (bf16)s1.y; bv[6] = (bf16)s1.z; bv[7] = (bf16)s1.w;
        facc[pt] = mfma32(cfrag[ks], bv, facc[pt]);
      }
#pragma unroll
    for (int reg = 0; reg < 16; ++reg) {
      int lr = 32 * w + (reg & 3) + 8 * (reg >> 2) + 4 * h;
      float sc = d == 0 ? __expf(acs[lr]) : __expf(acs[128 + 127] - (acs[128 + lr] - das[128 + lr]));
      yacc[0][reg] += sc * facc[0][reg];
      yacc[1][reg] += sc * facc[1][reg];
    }
  }
  const bf16* P = (const bf16*)(wsp(p) + OFF_P);
  bf16* yo = (bf16*)(wsp(p) + OFF_YB) + (size_t)2 * TROWS * 384;
  const float dsk = p.in[26][l * 6 + hh];
#pragma unroll
  for (int pt = 0; pt < 2; ++pt)
#pragma unroll
    for (int reg = 0; reg < 16; ++reg) {
      int lr = 32 * w + (reg & 3) + 8 * (reg >> 2) + 4 * h;
      int pp = 32 * pt + r;
      float x = (float)Xt[pp * 136 + lr];
      float y = yacc[pt][reg] + dsk * x;
      float z = (float)P[(size_t)(R0 + lr) * PLD + PC_Z + hh * 64 + pp];
      yo[(size_t)(R0 + lr) * 384 + hh * 64 + pp] = (bf16)(y * silu_f(z));
    }
  __syncthreads();
}

__device__ NOPK void mla_fin_item(const Params& p, int l, int item) {
  const int sub = tidx() >> 5, ln = tidx() & 31;
  const bf16* P = (const bf16*)(wsp(p) + OFF_P);
  float e0[4], e1[4], e2[4];
  bf16* base[4]; int jj[4]; bool isKv[4];
#pragma unroll
  for (int q = 0; q < 4; ++q) {
    const int u = item * 32 + q * 8 + sub;
    const bool isK = u >= TROWS * 6;
    const int uu = isK ? u - TROWS * 6 : u;
    const int row = uu / 6, head = uu % 6;
    jj[q] = row % SEG; isKv[q] = isK;
    base[q] = isK ? (bf16*)(wsp(p) + OFF_KF) + (size_t)row * KLD + head * 96 : (bf16*)(wsp(p) + OFF_Q) + (size_t)row * QLD + head * 96;
    e0[q] = (float)base[q][ln]; e1[q] = (float)base[q][32 + ln];
    e2[q] = isK ? (float)P[(size_t)row * PLD + PC_KR + ln] : (float)base[q][64 + ln];
  }
#pragma unroll
  for (int q = 0; q < 4; ++q) {
    float ss = e0[q] * e0[q] + e1[q] * e1[q] + e2[q] * e2[q];
    for (int o = 16; o > 0; o >>= 1) ss += __shfl_xor(ss, o);
    const float rinv = rsqrtf(ss * (1.f / 96.f) + 1e-6f);
    const float* gn = p.in[isKv[q] ? 33 : 32] + l * 96;
    float a0 = e0[q] * rinv * gn[ln], a1 = e1[q] * rinv * gn[32 + ln], a2 = e2[q] * rinv * gn[64 + ln];
    float other = __shfl_xor(a2, 16);
    if (jj[q] >= CTXL) {
      int pos = jj[q] - CTXL;
      int i = ln & 15;
      float pv = (i < 8) ? (float)(pos >> 6) : (float)(pos & 63);
      float inv = powf(10000.f, -(float)(i & 7) / 8.f);
      float ang = pv * inv;
      float cs = cosf(ang), sn = sinf(ang);
      a2 = (ln < 16) ? (a2 * cs - other * sn) : (other * sn + a2 * cs);
    }
    const float qs = isKv[q] ? 1.f : 0.10206207262f * 1.44269504089f;
    base[q][ln] = (bf16)(a0 * qs); base[q][32 + ln] = (bf16)(a1 * qs); base[q][64 + ln] = (bf16)(a2 * qs);
  }
}

__device__ NOPK void attn_item(const Params& p, int l, int item, char* smem) {
  int b, head, qb;
  if (item < 768) { qb = 2 + item % 64; head = (item / 64) % 6; b = item / 384; }
  else { int i2 = item - 768; qb = i2 % 2; head = (i2 / 2) % 6; b = i2 / 12; }
  const int nkeys = qb < 2 ? CTXL : SEG;
  const int tid = tidx(), lane = tid & 63, w = tid >> 6, r = lane & 31, h = lane >> 5;
  bf16* Ks = (bf16*)smem;
  bf16* Vs = Ks + 2 * 64 * 104;
  const bf16* Q = (const bf16*)(wsp(p) + OFF_Q);
  const bf16* KF = (const bf16*)(wsp(p) + OFF_KF);
  const bf16* VT = (const bf16*)(wsp(p) + OFF_VT) + (size_t)(b * 6 + head) * 64 * SEG;
  float mq = 0.f, mk = 0.f;
  for (int i = 0; i < 96; ++i) { mq = fmaxf(mq, fabsf(p.in[32][l * 96 + i])); mk = fmaxf(mk, fabsf(p.in[33][l * 96 + i])); }
  const float mb = 9.79795897f * 1.44269504089f * mq * mk * 1.0001f;
  const float nmb = -mb;
  bf16x8 qf[6];
  {
    const bf16* qp = Q + (size_t)(b * SEG + qb * 128 + 32 * w + r) * QLD + head * 96 + 8 * h;
#pragma unroll
    for (int ks = 0; ks < 6; ++ks) qf[ks] = *(const bf16x8*)(qp + 16 * ks);
  }
  f32x16 oacc[2] = {zero16(), zero16()};
  float lsum = 0.f;
  uint4 pk0, pk1, pk2, pv0, pv1;
  uint4 qk0, qk1, qk2, qv0, qv1;
  const bf16* kbase = KF + (size_t)(b * SEG) * KLD + head * 96;
  const int c0 = tid, c1 = tid + 256, c2 = tid + 512;
  const bf16* kg0 = kbase + (size_t)(c0 / 12) * KLD + (c0 % 12) * 8;
  const bf16* kg1 = kbase + (size_t)(c1 / 12) * KLD + (c1 % 12) * 8;
  const bf16* kg2 = kbase + (size_t)(c2 / 12) * KLD + (c2 % 12) * 8;
  const bf16* vg0 = VT + (size_t)(c0 >> 3) * SEG + (c0 & 7) * 8;
  const bf16* vg1 = VT + (size_t)(c1 >> 3) * SEG + (c1 & 7) * 8;
  const int ko0 = (c0 / 12) * 104 + (c0 % 12) * 8, ko1 = (c1 / 12) * 104 + (c1 % 12) * 8, ko2 = (c2 / 12) * 104 + (c2 % 12) * 8;
  const int vo0 = (c0 >> 3) * 72 + (c0 & 7) * 8, vo1 = (c1 >> 3) * 72 + (c1 & 7) * 8;
  const int nt = nkeys / 64;
#define AGLOAD(S, t) { const size_t kof = (size_t)(t) * 64 * KLD; const int vof = (t) * 64; \
  S##k0 = ldg16(kg0 + kof); S##k1 = ldg16(kg1 + kof); S##k2 = ldg16(kg2 + kof); S##v0 = ldg16(vg0 + vof); S##v1 = ldg16(vg1 + vof); }
#define ASTORE(S, buf) { \
  *(uint4*)(Ks + (buf) * 64 * 104 + ko0) = S##k0; *(uint4*)(Ks + (buf) * 64 * 104 + ko1) = S##k1; *(uint4*)(Ks + (buf) * 64 * 104 + ko2) = S##k2; \
  *(uint4*)(Vs + (buf) * 64 * 72 + vo0) = S##v0; *(uint4*)(Vs + (buf) * 64 * 72 + vo1) = S##v1; }
#define ACOMPUTE(buf) { \
    const bf16* ks_ = Ks + (buf) * 64 * 104; \
    const bf16* vs_ = Vs + (buf) * 64 * 72; \
    _Pragma("unroll") for (int sub = 0; sub < 2; ++sub) { \
      f32x16 s = splat16(nmb); \
      _Pragma("unroll") for (int ks = 0; ks < 6; ++ks) { \
        bf16x8 a = *(const bf16x8*)(ks_ + (32 * sub + r) * 104 + 16 * ks + 8 * h); \
        s = mfma32(a, qf[ks], s); } \
      bf16x8 pf[2]; \
      _Pragma("unroll") for (int reg = 0; reg < 16; ++reg) { \
        float e = __builtin_amdgcn_exp2f(s[reg]); lsum += e; pf[reg >> 3][reg & 7] = (bf16)e; } \
      _Pragma("unroll") for (int k2 = 0; k2 < 2; ++k2) \
        _Pragma("unroll") for (int dt = 0; dt < 2; ++dt) { \
          const bf16* vp = vs_ + (32 * dt + r) * 72 + 32 * sub + 16 * k2 + 4 * h; \
          bf16x4 lo = *(const bf16x4*)vp, hi = *(const bf16x4*)(vp + 8); \
          bf16x8 va; \
          _Pragma("unroll") for (int e = 0; e < 4; ++e) { va[e] = lo[e]; va[4 + e] = hi[e]; } \
          oacc[dt] = mfma32(va, pf[k2], oacc[dt]); } } }
  AGLOAD(p, 0)
  AGLOAD(q, 1)
  for (int kt = 0; kt < nt; kt += 2) {
    ASTORE(p, 0)
    __syncthreads();
    if (kt + 2 < nt) AGLOAD(p, kt + 2)
    ACOMPUTE(0)
    ASTORE(q, 1)
    __syncthreads();
    if (kt + 3 < nt) AGLOAD(q, kt + 3)
    ACOMPUTE(1)
  }
#undef AGLOAD
#undef ASTORE
#undef ACOMPUTE
  __syncthreads();
  lsum += __shfl_xor(lsum, 32);
  const float linv = 1.f / lsum;
  bf16* yo = (bf16*)(wsp(p) + OFF_YB) + (size_t)3 * TROWS * 384;
  const size_t orow = (size_t)(b * SEG + qb * 128 + 32 * w + r) * 384 + head * 64;
#pragma unroll
  for (int dt = 0; dt < 2; ++dt)
#pragma unroll
    for (int g4 = 0; g4 < 4; ++g4) {
      int dv = 32 * dt + 8 * g4 + 4 * h;
      uint2 u;
      u.x = pack2(oacc[dt][4 * g4] * linv, oacc[dt][4 * g4 + 1] * linv);
      u.y = pack2(oacc[dt][4 * g4 + 2] * linv, oacc[dt][4 * g4 + 3] * linv);
      *(uint2*)(yo + orow + dv) = u;
    }
}

__device__ NOPK void pgemm_item(const Params& p, int it, char* smem) {
  char* ws = wsp(p);
  int mt = it / 23, nt = it % 23;
  f32x16 acc[4][2];
#pragma unroll
  for (int i = 0; i < 4; ++i) { acc[i][0] = zero16(); acc[i][1] = zero16(); }
  gemm_core_big(acc, (const bf16*)(ws + OFF_H) + (size_t)mt * 256 * DM, DM, (const bf16*)(ws + OFF_WIN) + (size_t)nt * 128 * DM, DM, DM, smem);
  bf16* P = (bf16*)(ws + OFF_P) + (size_t)mt * 256 * PLD + nt * 128;
  const int lane = tidx() & 63, w = tidx() >> 6, wm = w >> 1, wn = w & 1, r = lane & 31, h = lane >> 5;
#pragma unroll
  for (int mi = 0; mi < 4; ++mi)
#pragma unroll
    for (int ni = 0; ni < 2; ++ni)
#pragma unroll
      for (int reg = 0; reg < 16; ++reg) {
        int row = wm * 128 + mi * 32 + (reg & 3) + 8 * (reg >> 2) + 4 * h;
        gst(P + (size_t)row * PLD + wn * 64 + ni * 32 + r, (bf16)acc[mi][ni][reg]);
      }
}
__device__ NOPK void mlaq_item(const Params& p, int it, char* smem) {
  char* ws = wsp(p);
  float* rs = (float*)(smem + 73728);
  int mt = it / 5, nt = it % 5;
  const bf16* A = (const bf16*)(ws + OFF_P) + (size_t)mt * 128 * PLD + PC_CQ;
  row_rms(A, PLD, 384, 1e-6f, rs);
  f32x16 acc[2][2]; zero_acc(acc);
  gemm_core(acc, A, PLD, (const bf16*)(ws + OFF_WUQ) + (size_t)nt * 128 * 384, 384, 384, smem);
  bf16* Q = (bf16*)(ws + OFF_Q) + (size_t)mt * 128 * QLD + nt * 128;
  gemm_epi(acc, [&](int row, int col, float v) NOPK { gst(Q + (size_t)row * QLD + col, (bf16)(v * rs[row])); });
  __syncthreads();
}
__device__ NOPK void mlakv_item(const Params& p, int it, char* smem) {
  char* ws = wsp(p);
  float* rs = (float*)(smem + 73728);
  int mt = it / 6, nt = it % 6;
  const bf16* A = (const bf16*)(ws + OFF_P) + (size_t)mt * 128 * PLD + PC_CKV;
  row_rms(A, PLD, 256, 1e-6f, rs);
  f32x16 acc[2][2]; zero_acc(acc);
  gemm_core(acc, A, PLD, (const bf16*)(ws + OFF_WUKV) + (size_t)nt * 128 * 256, 256, 256, smem);
  const int R0 = mt * 128, b = R0 / SEG, j0 = R0 % SEG;
  bf16* KFp = (bf16*)(ws + OFF_KF) + (size_t)R0 * KLD + nt * 96;
  bf16* VTp = (bf16*)(ws + OFF_VT) + (size_t)(b * 6 + nt) * 64 * SEG + j0;
  {
    const int lane = tidx() & 63, w = tidx() >> 6, wm = w >> 1, wn = w & 1, r = lane & 31, h = lane >> 5;
#pragma unroll
    for (int mi = 0; mi < 2; ++mi)
#pragma unroll
      for (int ni = 0; ni < 2; ++ni)
#pragma unroll
        for (int g4 = 0; g4 < 4; ++g4) {
          const int row0 = wm * 64 + mi * 32 + 8 * g4 + 4 * h, col = wn * 64 + ni * 32 + r;
          float o0 = acc[mi][ni][4 * g4] * rs[row0], o1 = acc[mi][ni][4 * g4 + 1] * rs[row0 + 1];
          float o2 = acc[mi][ni][4 * g4 + 2] * rs[row0 + 2], o3 = acc[mi][ni][4 * g4 + 3] * rs[row0 + 3];
          if (wn == 0) {
            KFp[(size_t)row0 * KLD + col] = (bf16)o0; KFp[(size_t)(row0 + 1) * KLD + col] = (bf16)o1;
            KFp[(size_t)(row0 + 2) * KLD + col] = (bf16)o2; KFp[(size_t)(row0 + 3) * KLD + col] = (bf16)o3;
          } else {
            uint2 u; u.x = pack2(o0, o1); u.y = pack2(o2, o3);
            *(uint2*)(VTp + (size_t)(col - 64) * SEG + row0) = u;
          }
        }
  }
  __syncthreads();
}
__device__ NOPK void glu_item(const Params& p, int it, char* smem) {
  char* ws = wsp(p);
  int mt = it / 3, nt = it % 3;
  f32x16 acc[2][2]; zero_acc(acc);
  const bf16* A = (const bf16*)(ws + OFF_YS5) + (size_t)mt * 128 * 384;
  gemm_core(acc, A, 384, (const bf16*)(ws + OFF_WGLU) + (size_t)nt * 128 * 384, 384, 384, smem);
  bf16* yo = (bf16*)(ws + OFF_YB) + (size_t)mt * 128 * 384 + nt * 128;
  const bf16* yi = A + nt * 128;
  gemm_epi(acc, [&](int row, int col, float v) NOPK {
    float a = (float)gld(yi + (size_t)row * 384 + col);
    gst(yo + (size_t)row * 384 + col, (bf16)(a * sigm(v)));
  });
}
__device__ NOPK void merge_item(const Params& p, int it, char* smem) {
  char* ws = wsp(p);
  const int tid = tidx();
  int mt = it / 16, nt = it % 16;
  float* rs = (float*)(smem + 73728);
  const bf16* Ah = (const bf16*)(ws + OFF_H) + (size_t)mt * 128 * DM;
  const bf16* Wg = (const bf16*)(ws + OFF_WG) + (size_t)(nt * 64) * DM;
  const bf16* Yb = (const bf16*)(ws + OFF_YB) + (size_t)(mt * 128) * 384;
  const bf16* Wb = (const bf16*)(ws + OFF_WBR) + (size_t)(nt * 64) * 384;
  Stage6 P, Q;
  {
    const int srow = tid >> 3, spart = tid & 7;
    chain_load(P, Ah + (size_t)srow * DM + spart * 8, DM, Wg + (size_t)srow * DM + spart * 8, DM, 0);
    chain_load(Q, Ah + (size_t)srow * DM + spart * 8, DM, Wg + (size_t)srow * DM + spart * 8, DM, BKK);
  }
  row_rms((const bf16*)(ws + OFF_YB) + ((size_t)2 * TROWS + mt * 128) * 384, 384, 384, 1e-6f, rs);
  const int lane = tid & 63, w = tid >> 6, wm = w >> 1, wn = w & 1, r = lane & 31, h = lane >> 5;
  f32x16 macc[2][1]; macc[0][0] = zero16(); macc[1][0] = zero16();
#pragma unroll 1
  for (int br = 0; br < 4; ++br) {
    const bf16* Ab = Yb + (size_t)br * TROWS * 384;
    const bf16* Bb = Wb + (size_t)br * 1024 * 384;
    unsigned gs[2][8];
    {
      f32x16 gacc[2][1]; gacc[0][0] = zero16(); gacc[1][0] = zero16();
      gemm_chain(gacc, P, Q, Ah, DM, Wg + (size_t)br * 1024 * DM, DM, DM, Ab, 384, Bb, 384, smem);
#pragma unroll
      for (int mi = 0; mi < 2; ++mi)
#pragma unroll
        for (int q = 0; q < 8; ++q) gs[mi][q] = pack2(sigm(gacc[mi][0][2 * q]), sigm(gacc[mi][0][2 * q + 1]));
    }
    f32x16 bacc[2][1]; bacc[0][0] = zero16(); bacc[1][0] = zero16();
    gemm_chain(bacc, P, Q, Ab, 384, Bb, 384, 384, br < 3 ? Ah : (const bf16*)nullptr, DM, Wg + (size_t)(br < 3 ? br + 1 : 0) * 1024 * DM, DM, smem);
#pragma unroll
    for (int mi = 0; mi < 2; ++mi)
#pragma unroll
      for (int reg = 0; reg < 16; ++reg) {
        unsigned u = gs[mi][reg >> 1];
        float gate = __uint_as_float((reg & 1) ? (u & 0xffff0000u) : (u << 16));
        int row = wm * 64 + mi * 32 + (reg & 3) + 8 * (reg >> 2) + 4 * h;
        float sc = br == 2 ? rs[row] : 1.f;
        macc[mi][0][reg] += gate * sc * bacc[mi][0][reg];
      }
  }
  bf16* MG = (bf16*)(ws + OFF_MG) + (size_t)mt * 128 * DM + nt * 64;
#pragma unroll
  for (int mi = 0; mi < 2; ++mi)
#pragma unroll
    for (int reg = 0; reg < 16; ++reg) {
      int row = wm * 64 + mi * 32 + (reg & 3) + 8 * (reg >> 2) + 4 * h;
      gst(MG + (size_t)row * DM + wn * 32 + r, (bf16)macc[mi][0][reg]);
    }
  __syncthreads();
}
__device__ __forceinline__ NOPK void n1024_tile(int it, int& mt, int& n0, bool& half) {
  if (it < 992) { mt = it >> 3; n0 = (it & 7) * 128; half = false; }
  else { int hh = it - 992; int tile = 992 + (hh >> 1); mt = tile >> 3; n0 = (tile & 7) * 128 + (hh & 1) * 64; half = true; }
}
__device__ NOPK void wout_item(const Params& p, int l, int it, char* smem) {
  char* ws = wsp(p);
  int mt, n0; bool half;
  n1024_tile(it, mt, n0, half);
  const int R0 = mt * 128, b = R0 / SEG, j0 = R0 % SEG, v = j0 < CTXL ? 2 : b;
  const float* g1 = (const float*)(ws + OFF_MOD) + (size_t)(l * 3 + v) * 6144 + 2048 + n0;
  float* X = (float*)(ws + OFF_X) + (size_t)R0 * DM + n0;
  const bf16* A = (const bf16*)(ws + OFF_MG) + (size_t)mt * 128 * DM;
  const bf16* B = (const bf16*)(ws + OFF_WOUT) + (size_t)n0 * DM;
  const int lane = tidx() & 63, w = tidx() >> 6, wm = w >> 1, wn = w & 1, r = lane & 31, h = lane >> 5;
  if (!half) {
    f32x16 acc[2][2]; zero_acc(acc);
    gemm_core(acc, A, DM, B, DM, DM, smem);
    gemm_epi(acc, [&](int row, int col, float val) NOPK { float* xp = X + (size_t)row * DM + col; gst(xp, gld(xp) + gld(g1 + col) * val); });
  } else {
    f32x16 acc[2][1]; acc[0][0] = zero16(); acc[1][0] = zero16();
    gemm_core_t<1>(acc, A, DM, B, DM, DM, smem);
#pragma unroll
    for (int mi = 0; mi < 2; ++mi)
#pragma unroll
      for (int reg = 0; reg < 16; ++reg) {
        int row = wm * 64 + mi * 32 + (reg & 3) + 8 * (reg >> 2) + 4 * h, col = wn * 32 + r;
        { float* xp = X + (size_t)row * DM + col; gst(xp, gld(xp) + gld(g1 + col) * acc[mi][0][reg]); }
      }
  }
}
__device__ NOPK void ffi_item(const Params& p, int it, char* smem) {
  char* ws = wsp(p);
  int mt = it / 44, nt = it % 44;
  f32x16 acc[4][2];
#pragma unroll
  for (int i = 0; i < 4; ++i) { acc[i][0] = zero16(); acc[i][1] = zero16(); }
  gemm_core_big(acc, (const bf16*)(ws + OFF_H) + (size_t)mt * 256 * DM, DM, (const bf16*)(ws + OFF_WFI) + (size_t)nt * 128 * DM, DM, DM, smem);
  bf16* HID = (bf16*)(ws + OFF_HID) + (size_t)mt * 256 * FFH + nt * 64;
  const int lane = tidx() & 63, w = tidx() >> 6, wm = w >> 1, wn = w & 1, r = lane & 31, h = lane >> 5;
#pragma unroll
  for (int mi = 0; mi < 4; ++mi)
#pragma unroll
    for (int reg = 0; reg < 16; ++reg) {
      int row = wm * 128 + mi * 32 + (reg & 3) + 8 * (reg >> 2) + 4 * h;
      float gv = acc[mi][0][reg], uv = acc[mi][1][reg];
      gst(HID + (size_t)row * FFH + wn * 32 + r, (bf16)(silu_f(gv) * uv));
    }
}
__device__ NOPK void ffo_item(const Params& p, int l, int it, char* smem) {
  char* ws = wsp(p);
  int mt, n0; bool half;
  n1024_tile(it, mt, n0, half);
  const int R0 = mt * 128, b = R0 / SEG, j0 = R0 % SEG, v = j0 < CTXL ? 2 : b;
  const float* g2 = (const float*)(ws + OFF_MOD) + (size_t)(l * 3 + v) * 6144 + 5120 + n0;
  float* X = (float*)(ws + OFF_X) + (size_t)R0 * DM + n0;
  float* O = p.out + ((size_t)b * 8192 + (j0 - CTXL)) * DM + n0;
  const bool wr = (l == 3) && (j0 >= CTXL);
  const bf16* A = (const bf16*)(ws + OFF_HID) + (size_t)mt * 128 * FFH;
  const bf16* B = (const bf16*)(ws + OFF_WFO) + (size_t)n0 * FFH;
  const int lane = tidx() & 63, w = tidx() >> 6, wm = w >> 1, wn = w & 1, r = lane & 31, h = lane >> 5;
  if (!half) {
    f32x16 acc[2][2]; zero_acc(acc);
    gemm_core(acc, A, FFH, B, FFH, FFH, smem);
    gemm_epi(acc, [&](int row, int col, float val) NOPK {
      float* xp = X + (size_t)row * DM + col;
      float xn = gld(xp) + gld(g2 + col) * val;
      gst(xp, xn);
      if (wr) gst(O + (size_t)row * DM + col, xn);
    });
  } else {
    f32x16 acc[2][1]; acc[0][0] = zero16(); acc[1][0] = zero16();
    gemm_core_t<1>(acc, A, FFH, B, FFH, FFH, smem);
#pragma unroll
    for (int mi = 0; mi < 2; ++mi)
#pragma unroll
      for (int reg = 0; reg < 16; ++reg) {
        int row = wm * 64 + mi * 32 + (reg & 3) + 8 * (reg >> 2) + 4 * h, col = wn * 32 + r;
        float* xp = X + (size_t)row * DM + col;
        float xn = gld(xp) + gld(g2 + col) * acc[mi][0][reg];
        gst(xp, xn);
        if (wr) gst(O + (size_t)row * DM + col, xn);
      }
  }
}
__device__ NOPK void p0a_item(const Params& p, int it) {
  char* ws = wsp(p);
  const int tid = tidx();
  if (it < 1536) {
    int kc = it % 16, nc = (it / 16) % 24, l = it / 384;
    int n = nc * 256 + tid;
    const float* wa = p.in[4] + (size_t)l * 1024 * 6144 + n;
    float a0 = 0.f, a1 = 0.f, a2 = 0.f;
    for (int k = kc * 64; k < kc * 64 + 64; ++k) {
      float wv = wa[(size_t)k * 6144];
      a0 += silu_f(p.in[1][k]) * wv; a1 += silu_f(p.in[1][1024 + k]) * wv; a2 += silu_f(p.in[3][k]) * wv;
    }
    float* mp = (float*)(ws + OFF_MODP) + (size_t)(l * 16 + kc) * 3 * 6144;
    mp[n] = a0; mp[6144 + n] = a1; mp[2 * 6144 + n] = a2;
  } else {
    int i2 = it - 1536;
    for (int rr = 0; rr < 4; ++rr) {
      int row = i2 * 4 + rr;
      int b = row / SEG, j = row % SEG;
      const float* src = j < CTXL ? p.in[2] + ((size_t)b * CTXL + j) * DM : p.in[0] + ((size_t)b * 8192 + (j - CTXL)) * DM;
      ((float4*)(ws + OFF_X))[(size_t)row * 256 + tid] = ((const float4*)src)[tid];
    }
  }
}
__device__ NOPK void p0b_item(const Params& p, int it) {
  char* ws = wsp(p);
  int e = it * 256 + tidx();
  int n = e % 6144, v = (e / 6144) % 3, l = e / (3 * 6144);
  float s = p.in[5][l * 6144 + n];
  const float* mp = (const float*)(ws + OFF_MODP) + (size_t)l * 16 * 3 * 6144 + v * 6144 + n;
  for (int kc = 0; kc < 16; ++kc) s += mp[(size_t)kc * 3 * 6144];
  ((float*)(ws + OFF_MOD))[e] = s;
}

__device__ __forceinline__ NOPK void grid_barrier(unsigned* ctl, unsigned k, int nb, int bid) {
  asm volatile("s_waitcnt vmcnt(0)" ::: "memory");
  __syncthreads();
  if (__builtin_amdgcn_workitem_id_x() == 0) {
    __builtin_amdgcn_fence(__ATOMIC_RELEASE, "agent");
    asm volatile("s_waitcnt vmcnt(0)" ::: "memory");
    const int leaf = bid & 63;
    unsigned old = __hip_atomic_fetch_add(ctl + 256 + leaf * 8, 1u, __ATOMIC_RELAXED, __HIP_MEMORY_SCOPE_AGENT);
    if (old + 1 == k * (unsigned)(nb >> 6)) {
      unsigned o1 = __hip_atomic_fetch_add(ctl + 176 + (leaf & 7) * 8, 1u, __ATOMIC_RELAXED, __HIP_MEMORY_SCOPE_AGENT);
      if (o1 + 1 == k * 8u) {
        unsigned o2 = __hip_atomic_fetch_add(ctl, 1u, __ATOMIC_RELAXED, __HIP_MEMORY_SCOPE_AGENT);
        if (o2 + 1 == k * 8u) __hip_atomic_store(ctl + 16, k, __ATOMIC_RELAXED, __HIP_MEMORY_SCOPE_AGENT);
      }
    }
    while (__hip_atomic_load(ctl + 16, __ATOMIC_RELAXED, __HIP_MEMORY_SCOPE_AGENT) < k) __builtin_amdgcn_s_sleep(4);
    __builtin_amdgcn_fence(__ATOMIC_ACQUIRE, "agent");
    asm volatile("s_waitcnt vmcnt(0)" ::: "memory");
  }
  __syncthreads();
}
__device__ __forceinline__ NOPK int next_item(unsigned* head, char* smem, int nb) {
  int* sh = (int*)(smem + LDS_BYTES - 16);
  __syncthreads();
  if (__builtin_amdgcn_workitem_id_x() == 0) *sh = nb + (int)__hip_atomic_fetch_add(head, 1u, __ATOMIC_RELAXED, __HIP_MEMORY_SCOPE_AGENT);
  __syncthreads();
  return *sh;
}

__global__ NOPK void __launch_bounds__(256, 2) mega(Params p) {
  cg::grid_group grid = cg::this_grid();
  extern __shared__ __attribute__((aligned(16))) unsigned char lds[];
  char* smem = (char*)lds;
  const int nb = p.nblk, bid = __builtin_amdgcn_workgroup_id_x();
  const int lo = p.ph_lo, hi = p.ph_hi;
  unsigned* ctl = (unsigned*)(p.ws + OFF_CTL);
  unsigned nbar = 0;
  if (lo > 4096) grid.sync();
#define PHASE_BEGIN(n) if ((n) >= lo && (n) < hi) {
#define PHASE_END(n) if ((n) + 1 < hi) { \
    ++nbar; grid_barrier(ctl, nbar, nb, bid); } }
#ifdef DBG_PH
  if (lo == 100) {
#ifdef DBG_F32_OFF
    const float* Fq = (const float*)(p.ws + DBG_F32_OFF);
    for (size_t i = (size_t)bid * 256 + __builtin_amdgcn_workitem_id_x(); i < (size_t)2 * 8192 * 1024; i += (size_t)nb * 256)
      { float q = DBG_K * Fq[i % (size_t)DBG_N]; p.out[i] = q - floorf(q); }
#elif defined(DBG_BF16_OFF)
    const bf16* Bq = (const bf16*)(p.ws + DBG_BF16_OFF);
    for (size_t i = (size_t)bid * 256 + __builtin_amdgcn_workitem_id_x(); i < (size_t)2 * 8192 * 1024; i += (size_t)nb * 256)
      { float q = DBG_K * (float)Bq[i % (size_t)DBG_N]; p.out[i] = q - floorf(q); }
#else
    const float* X = (const float*)(p.ws + OFF_X);
    for (size_t i = (size_t)bid * 256 + __builtin_amdgcn_workitem_id_x(); i < (size_t)2 * 8192 * 1024; i += (size_t)nb * 256) {
      size_t row = i / 1024, c = i % 1024; size_t b = row / 8192, j = row % 8192;
      size_t xr = row < 512 ? (row / 256) * SEG + (row % 256) : b * SEG + CTXL + j;
      { float q = DBG_K * X[xr * 1024 + c]; p.out[i] = q - floorf(q); }
    }
#endif
    return;
  }
#endif

  PHASE_BEGIN(0)
  for (int it = bid; it < 1536 + 4224; it += nb) p0a_item(p, it);
  PHASE_END(0)
  PHASE_BEGIN(1)
  for (int it = bid; it < 288; it += nb) p0b_item(p, it);
  PHASE_END(1)

  for (int l = 0; l < 4; ++l) {
    const int pb = 2 + 10 * l;
    PHASE_BEGIN(pb + 0)
    for (int it = bid; it < WPREP_ITEMS + 4224; it += nb) {
      if (it < WPREP_ITEMS) wprep_item(p, l, it, smem);
      else norm_item(p, l, 0, it - WPREP_ITEMS);
    }
    PHASE_END(pb + 0)
    for (int rep = 0; rep < ((REPEAT_MASK >> 1) & 1) + 1; ++rep) {
    PHASE_BEGIN(pb + 1)
    for (int it = bid; it < 66 * 23; it += nb) pgemm_item(p, it, smem);
    PHASE_END(pb + 1)
    }
    for (int rep = 0; rep < ((REPEAT_MASK >> 2) & 1) + 1; ++rep) {
    PHASE_BEGIN(pb + 2)
    {
      constexpr int N_Q = 132 * 5, N_KV = 132 * 6, N_SGU = 792, N_S5A = 2 * 132 * 2 * 6, N_SSDA = 792;
      for (int it0 = bid; it0 < N_Q + N_KV + N_SGU + N_S5A + N_SSDA; it0 = next_item(ctl + 64 + pb + 2 + 48 * rep, smem, nb)) {
        int it = it0;
        if (it < N_Q) { mlaq_item(p, it, smem); continue; }
        it -= N_Q;
        if (it < N_KV) { mlakv_item(p, it, smem); continue; }
        it -= N_KV;
        if (it < N_SGU) { sgu_item(p, l, it, smem); continue; }
        it -= N_SGU;
        if (it < N_S5A) { s5a_item(p, it, smem); continue; }
        it -= N_S5A;
        ssda_item(p, l, it, smem);
      }
    }
    PHASE_END(pb + 2)
    }
    PHASE_BEGIN(pb + 3)
    {
      constexpr int N_S5B = 2 * 132 * 6, N_CAR = 384, N_FIN = 2 * TROWS * 6 / 32;
      for (int it0 = bid; it0 < N_S5B + N_CAR + N_FIN; it0 += nb) {
        int it = it0;
        if (it < N_S5B) { s5b_item(p, l, it, smem); continue; }
        it -= N_S5B;
        if (it < N_CAR) { ssd_carry_item(p, it); continue; }
        it -= N_CAR;
        mla_fin_item(p, l, it);
      }
    }
    PHASE_END(pb + 3)
    for (int rep = 0; rep < ((REPEAT_MASK >> 4) & 1) + 1; ++rep) {
    PHASE_BEGIN(pb + 4)
    {
      constexpr int N_ATT = 792, N_SSDB = 792, N_GLU = 132 * 3;
      for (int it = bid; it < N_ATT + N_SSDB + N_GLU; it = next_item(ctl + 64 + pb + 4 + 48 * rep, smem, nb)) {
        if (it < N_ATT) { attn_item(p, l, it, smem); continue; }
        it -= N_ATT;
        if (it < N_SSDB) { ssdb_item(p, l, it, smem); continue; }
        it -= N_SSDB;
        glu_item(p, it, smem);
      }
    }
    PHASE_END(pb + 4)
    }
    for (int rep = 0; rep < ((REPEAT_MASK >> 5) & 1) + 1; ++rep) {
    PHASE_BEGIN(pb + 5)
    for (int it = bid; it < 132 * 16; it = next_item(ctl + 64 + pb + 5 + 48 * rep, smem, nb)) merge_item(p, it, smem);
    PHASE_END(pb + 5)
    }
    PHASE_BEGIN(pb + 6)
    for (int it = bid; it < 1120; it = next_item(ctl + 64 + pb + 6, smem, nb)) wout_item(p, l, it, smem);
    PHASE_END(pb + 6)
    PHASE_BEGIN(pb + 7)
    for (int it = bid; it < 4224; it += nb) norm_item(p, l, 1, it);
    PHASE_END(pb + 7)
    for (int rep = 0; rep < ((REPEAT_MASK >> 8) & 1) + 1; ++rep) {
    PHASE_BEGIN(pb + 8)
    for (int it = bid; it < 66 * 44; it += nb) ffi_item(p, it, smem);
    PHASE_END(pb + 8)
    }
    PHASE_BEGIN(pb + 9)
    for (int it = bid; it < 1120; it = next_item(ctl + 64 + pb + 9, smem, nb)) ffo_item(p, l, it, smem);
    PHASE_END(pb + 9)
  }
}

#ifndef N_LAUNCH_SPLIT
#define N_LAUNCH_SPLIT 0
#endif
extern "C" void kernel_launch(void* const* d_in, const int* in_sizes, int n_in, void* d_out, int out_size, void* d_ws,
                              size_t ws_size, hipStream_t stream) {
  static int grid_blocks = 0;
  if (!grid_blocks) {
    int dev = 0, cus = 0, per_cu = 0;
    (void)hipGetDevice(&dev);
    (void)hipDeviceGetAttribute(&cus, hipDeviceAttributeMultiprocessorCount, dev);
    (void)hipFuncSetAttribute((const void*)mega, hipFuncAttributeMaxDynamicSharedMemorySize, LDS_BYTES);
    (void)hipOccupancyMaxActiveBlocksPerMultiprocessor(&per_cu, mega, 256, LDS_BYTES);
    if (per_cu < 1) per_cu = 1;
    if (per_cu > 2) per_cu = 2;
    grid_blocks = cus * per_cu;
    if (ws_size < WS_TOTAL) fprintf(stderr, "kernel_launch: workspace too small: need %zu have %zu\n", (size_t)WS_TOTAL, ws_size);
  }
  Params p{};
  for (int i = 0; i < 38; ++i) p.in[i] = (const float*)d_in[i];
  p.out = (float*)d_out;
  p.ws = (char*)d_ws;
  p.nblk = grid_blocks; p.pad0 = 0;
  (void)hipMemsetAsync((char*)d_ws + OFF_CTL, 0, 4096, stream);
#if N_LAUNCH_SPLIT
#ifdef DBG_PH
  for (int ph = 0; ph <= DBG_PH; ++ph) {
    p.ph_lo = ph; p.ph_hi = ph + 1;
    hipLaunchKernelGGL(mega, dim3(grid_blocks), dim3(256), LDS_BYTES, stream, p);
  }
  p.ph_lo = 100; p.ph_hi = 101;
  hipLaunchKernelGGL(mega, dim3(grid_blocks), dim3(256), LDS_BYTES, stream, p);
#else
  for (int ph = 0; ph < 42; ++ph) {
    p.ph_lo = ph; p.ph_hi = ph + 1;
    hipLaunchKernelGGL(mega, dim3(grid_blocks), dim3(256), LDS_BYTES, stream, p);
  }
#endif
#else
  p.ph_lo = 0; p.ph_hi = 42;
  void* args[] = {&p};
  hipError_t e = hipLaunchCooperativeKernel((void*)mega, dim3(grid_blocks), dim3(256), args, LDS_BYTES, stream);
  if (e != hipSuccess) fprintf(stderr, "cooperative launch failed: %s (grid %d)\n", hipGetErrorString(e), grid_blocks);
#endif
}
#if defined(__HIP_DEVICE_COMPILE__)
#pragma clang attribute pop
#endif
```
